# Optimizing an MI355X kernel written in HIP

```python
import jax
import jax.numpy as jnp
from jax import lax
import numpy as np

D_MODEL = 1024
BATCH = 8
SEQ = 8192
DEPTH = 2

GRID_W = 64
CTX_LEN = 256
N_MIXERS = 2
D_FF = 2816
CONV_WIDTH = 3
HG_HEADS = 8
HG_DK = D_MODEL // HG_HEADS
HG_CHUNK = 64
N_CONV_LAYERS = (DEPTH + 1) // 2
N_HGRN_LAYERS = DEPTH // 2
N_MOD = 9
EPS = 1e-6

kernel_name = 'hybrid_shortconv_hgrn2_macaron_flow'


def rms_norm(x, g):
    xf = x.astype(jnp.float32)
    y = xf * lax.rsqrt(jnp.mean(xf * xf, axis=-1, keepdims=True) + EPS)
    return (y * g.astype(jnp.float32)).astype(x.dtype)


def ada_mods(cond, w, b):
    m = jax.nn.silu(cond) @ w + b
    return jnp.split(m[..., None, :], N_MOD, axis=-1)


def modulate(x, shift, scale):
    return x * (1.0 + scale) + shift


def swiglu(x, w_gu, w_down):
    gate, up = jnp.split(x @ w_gu, 2, axis=-1)
    return (jax.nn.silu(gate) * up) @ w_down


def ffn_half(h, shift, scale, gate, g, w_gu, w_down):
    return h + 0.5 * gate * swiglu(modulate(rms_norm(h, g), shift, scale), w_gu, w_down)


def conv3(z, w, axis):
    n = z.shape[axis]
    pad = [(0, 0)] * z.ndim
    pad[axis] = (1, 1)
    zp = jnp.pad(z, pad)
    return sum(lax.slice_in_dim(zp, j, j + n, axis=axis) * w[j] for j in range(CONV_WIDTH))


def grid_conv(z, w, rows):
    b, s, d = z.shape
    half = d // 2
    zg = z.reshape(b, rows, GRID_W, d)
    yh = conv3(zg[..., :half], w[:, :half], axis=2)
    yv = conv3(zg[..., half:], w[:, half:], axis=1)
    return jnp.concatenate([yh, yv], axis=-1).reshape(b, s, d)


def shortconv_mixer(a, w_in, conv_w, w_out, rows):
    bg, cg, v = jnp.split(a @ w_in, 3, axis=-1)
    z = cg * v
    zc = conv3(z, conv_w, axis=1) if rows is None else grid_conv(z, conv_w, rows)
    return (bg * zc) @ w_out


def hgrn_lower_bounds(lb_logits):
    p = jax.nn.softmax(lb_logits.astype(jnp.float32), axis=0)
    return jnp.cumsum(p, axis=0) - p[0]


def to_heads(t):
    return t.astype(jnp.float32).reshape(t.shape[0], t.shape[1], HG_HEADS, HG_DK)


def hgrn_gates(f_logit, lb):
    f = lb + (1.0 - lb) * jax.nn.sigmoid(f_logit.astype(jnp.float32))
    return to_heads(1.0 - f), to_heads(jnp.log(f))


def chunk_gla_scan(q, k, v, logf):
    b, l, h, dk = q.shape
    dv = v.shape[-1]
    n = l // HG_CHUNK

    def to_chunks(t):
        return jnp.moveaxis(t.reshape(b, n, HG_CHUNK, h, t.shape[-1]), 1, 0)

    mask = jnp.tril(jnp.ones((HG_CHUNK, HG_CHUNK), dtype=bool))

    def step(s, inp):
        qc, kc, vc, gc = inp
        g_cum = jnp.cumsum(gc, axis=1)
        q_t = qc * jnp.exp(g_cum)
        k_t = kc * jnp.exp(-g_cum)
        att = jnp.where(mask, jnp.einsum('bthd,bshd->bhts', q_t, k_t), 0.0)
        o = jnp.einsum('bhts,bshe->bthe', att, vc) + jnp.einsum('bthd,bhde->bthe', q_t, s)
        g_last = g_cum[:, -1]
        k_d = kc * jnp.exp(g_last[:, None] - g_cum)
        s = jnp.exp(g_last)[..., None] * s + jnp.einsum('bshd,bshe->bhde', k_d, vc)
        return s, o

    s0 = jnp.zeros((b, h, dk, dv), jnp.float32)
    _, o = lax.scan(step, s0, (to_chunks(q), to_chunks(k), to_chunks(v), to_chunks(logf)))
    return jnp.moveaxis(o, 0, 1).reshape(b, l, h, dv)


def prefix_reverse(t, lc):
    return jnp.concatenate([jnp.flip(t[:, :lc], axis=1), jnp.flip(t[:, lc:], axis=1)], axis=1)


def hgrn2_mixer(a_ctx, a_lat, w_in, lb_fwd, lb_bwd, gnorm_g, w_out, need_ctx):
    lc = a_ctx.shape[1]
    a = jnp.concatenate([a_ctx, a_lat], axis=1)
    q, i, f_fw, f_bw, og = jnp.split(a @ w_in, 5, axis=-1)
    q = to_heads(jax.nn.silu(q))
    i = to_heads(i)
    k_fw, lf_fw = hgrn_gates(f_fw, lb_fwd)
    k_bw, lf_bw = hgrn_gates(f_bw, lb_bwd)
    o_fw = chunk_gla_scan(q, k_fw, i, lf_fw)
    o_bw = prefix_reverse(chunk_gla_scan(prefix_reverse(q, lc), prefix_reverse(k_bw, lc),
                                         prefix_reverse(i, lc), prefix_reverse(lf_bw, lc)), lc)
    o = o_fw + o_bw
    if not need_ctx:
        o, og = o[:, lc:], og[:, lc:]
    o = o * lax.rsqrt(jnp.mean(o * o, axis=-1, keepdims=True) + EPS)
    o = o * gnorm_g.astype(jnp.float32).reshape(HG_HEADS, HG_DK)
    o = o.reshape(o.shape[0], o.shape[1], D_MODEL).astype(a.dtype)
    y = (o * jax.nn.silu(og)) @ w_out
    if need_ctx:
        return y[:, :lc], y[:, lc:]
    return None, y


def setup_inputs(seed: int = 0) -> dict:
    key = jax.random.key(seed)
    ks = jax.random.split(key, 17)
    d, f = D_MODEL, D_FF
    na, nb = N_CONV_LAYERS, N_HGRN_LAYERS

    def nrm(k, shape, scale=1.0):
        return scale * jax.random.normal(k, shape, jnp.float32)

    return {
        'x': nrm(ks[0], (BATCH, SEQ, d)),
        'c': nrm(ks[1], (BATCH, d)),
        'ctx': nrm(ks[2], (BATCH, CTX_LEN, d)),
        'c_ctx': nrm(ks[3], (d,)),
        'ada_w': nrm(ks[4], (DEPTH, d, N_MOD * d), 0.5 * d ** -0.5),
        'ada_b': nrm(ks[5], (DEPTH, N_MOD * d), 0.02),
        'norm_g': 1.0 + nrm(ks[6], (DEPTH, 3, d), 0.1),
        'ffn_w_gu': nrm(ks[7], (DEPTH, 2, d, 2 * f), d ** -0.5),
        'ffn_w_down': nrm(ks[8], (DEPTH, 2, f, d), f ** -0.5),
        'conv_w_in': nrm(ks[9], (na, d, 3 * d), d ** -0.5),
        'conv_w': nrm(ks[10], (na, CONV_WIDTH, d), CONV_WIDTH ** -0.5),
        'conv_w_out': nrm(ks[11], (na, d, d), d ** -0.5),
        'hg_w_in': nrm(ks[12], (nb, d, 5 * d), d ** -0.5),
        'hg_lb_logits': nrm(ks[13], (DEPTH, 2, d), 0.1),
        'hg_gnorm_g': 1.0 + nrm(ks[14], (nb, d), 0.1),
        'hg_w_out': nrm(ks[15], (nb, d, d), d ** -0.5),
        'final_norm_g': 1.0 + nrm(ks[16], (d,), 0.1),
    }


def reference(x, c, ctx, c_ctx, ada_w, ada_b, norm_g, ffn_w_gu, ffn_w_down, conv_w_in, conv_w,
              conv_w_out, hg_w_in, hg_lb_logits, hg_gnorm_g, hg_w_out, final_norm_g):
    rows = x.shape[1] // GRID_W
    lbs = hgrn_lower_bounds(hg_lb_logits)
    h, hc = x, ctx
    for layer in range(DEPTH):
        kind = layer % N_MIXERS
        j = layer // N_MIXERS
        last = layer == DEPTH - 1
        ctx_to_mixer = (kind == 1) or (not last)
        m = ada_mods(c, ada_w[layer], ada_b[layer])
        mc = ada_mods(c_ctx, ada_w[layer], ada_b[layer])
        g1, g2, g3 = norm_g[layer, 0], norm_g[layer, 1], norm_g[layer, 2]
        w_gu, w_dn = ffn_w_gu[layer], ffn_w_down[layer]
        h = ffn_half(h, m[0], m[1], m[2], g1, w_gu[0], w_dn[0])
        if ctx_to_mixer:
            hc = ffn_half(hc, mc[0], mc[1], mc[2], g1, w_gu[0], w_dn[0])
        a = modulate(rms_norm(h, g2), m[3], m[4])
        y_ctx = None
        if kind == 0:
            y = shortconv_mixer(a, conv_w_in[j], conv_w[j], conv_w_out[j], rows)
            if not last:
                ac = modulate(rms_norm(hc, g2), mc[3], mc[4])
                y_ctx = shortconv_mixer(ac, conv_w_in[j], conv_w[j], conv_w_out[j], None)
        else:
            ac = modulate(rms_norm(hc, g2), mc[3], mc[4])
            y_ctx, y = hgrn2_mixer(ac, a, hg_w_in[j], lbs[layer, 0], lbs[layer, 1],
                                   hg_gnorm_g[j], hg_w_out[j], not last)
        h = h + m[5] * y
        h = ffn_half(h, m[6], m[7], m[8], g3, w_gu[1], w_dn[1])
        if not last:
            hc = hc + mc[5] * y_ctx
            hc = ffn_half(hc, mc[6], mc[7], mc[8], g3, w_gu[1], w_dn[1])
    return rms_norm(h, final_norm_g)
```

```cpp
#include <hip/hip_runtime.h>
#include <hip/hip_cooperative_groups.h>
#include <cstdio>
namespace cg = cooperative_groups;

#define LAS __attribute__((address_space(3)))
#define DI __device__ __forceinline__
typedef unsigned short bf16_t;
typedef short bf16x8 __attribute__((ext_vector_type(8)));
typedef float f32x4 __attribute__((ext_vector_type(4)));
typedef unsigned u32x4 __attribute__((ext_vector_type(4)));
typedef unsigned u32x2 __attribute__((ext_vector_type(2)));

constexpr int D = 1024, NB = 8, SEQ = 8192, LC = 256, FF = 2816;
constexpr int ML = NB * SEQ;
constexpr int MC = NB * LC;
constexpr int MT = ML + MC;
constexpr int NMOD = 9 * D;
constexpr int SHW_LD = 5632;
constexpr float EPS = 1e-6f;
constexpr int NTHREADS = 512;
constexpr int LDS_BYTES = 131072 + 4096;
constexpr int NPHASES = 18;
#ifndef PHSEL
#define PHSEL 0x3FFFF
#endif
#define PHON(k) (((PHSEL) >> (k)) & 1)

constexpr size_t R2 = (size_t)MT * D * 2, L2B = (size_t)ML * D * 2;
constexpr size_t SZ_WGU1 = (size_t)2 * FF * D * 2, SZ_WDN1 = (size_t)D * FF * 2;
constexpr size_t OFF_WGU = 0;
constexpr size_t OFF_WDN = OFF_WGU + 4 * SZ_WGU1;
constexpr size_t OFF_WCIN = OFF_WDN + 4 * SZ_WDN1;
constexpr size_t OFF_WCOUT = OFF_WCIN + (size_t)3 * D * D * 2;
constexpr size_t OFF_WHIN = OFF_WCOUT + (size_t)D * D * 2;
constexpr size_t OFF_WHOUT = OFF_WHIN + (size_t)5 * D * D * 2;
constexpr size_t OFF_MODS = OFF_WHOUT + (size_t)D * D * 2;
constexpr size_t OFF_SHW = OFF_MODS + (size_t)2 * 9 * NMOD * 4;
constexpr size_t OFF_LB = OFF_SHW + (size_t)6 * 9 * SHW_LD * 4;
constexpr size_t OFF_SSQ = OFF_LB + 2 * 1024 * 4;
constexpr size_t OFF_HCTX = OFF_SSQ + (size_t)MT * 16 * 4;
constexpr size_t OFF_S0 = ((OFF_HCTX + (size_t)MC * D * 4 + 4095) / 4096) * 4096;
constexpr size_t OFF_S1 = OFF_S0 + R2;
constexpr size_t OFF_S2 = OFF_S1 + R2;
constexpr size_t OFF_S3 = OFF_S2 + R2;
constexpr size_t OFF_S4 = OFF_S3 + R2;
constexpr size_t OFF_S5 = OFF_S4 + L2B;
constexpr size_t OFF_S6 = OFF_S5 + L2B;
constexpr size_t WS_END = OFF_S6 + L2B;
static_assert((size_t)MT * FF * 2 <= 3 * R2, "act fits in S1..S3");
static_assert(WS_END <= (size_t)1073741824, "workspace budget");

struct Params {
    const float *x, *c, *ctx, *c_ctx, *ada_w, *ada_b, *norm_g, *w_gu, *w_dn, *cw_in, *cw, *cw_out, *hw_in, *lb_logits, *gnorm, *hw_out, *final_g;
    float* out; unsigned char* ws; int ph_lo, ph_hi;
};

DI unsigned cvt_pk_bf16(float lo, float hi) { typedef __bf16 bf2 __attribute__((ext_vector_type(2))); bf2 v = {(__bf16)lo, (__bf16)hi}; return __builtin_bit_cast(unsigned, v); }
DI unsigned pk_f16(float a, float b) { typedef _Float16 h2 __attribute__((ext_vector_type(2))); h2 v = {(_Float16)a, (_Float16)b}; return __builtin_bit_cast(unsigned, v); }
DI float bf_lo(unsigned u) { return __uint_as_float(u << 16); }
DI float bf_hi(unsigned u) { return __uint_as_float(u & 0xffff0000u); }
DI float silu_f(float x) { return x * __builtin_amdgcn_rcpf(1.f + __expf(-x)); }
DI float sigmoid_f(float x) { return __builtin_amdgcn_rcpf(1.f + __expf(-x)); }
DI u32x4 pack8(const f32x4 a, const f32x4 b) { u32x4 w; w.x = cvt_pk_bf16(a[0], a[1]); w.y = cvt_pk_bf16(a[2], a[3]); w.z = cvt_pk_bf16(b[0], b[1]); w.w = cvt_pk_bf16(b[2], b[3]); return w; }
DI float row_rstd(const float* ssq, int row) {
    const f32x4* p = (const f32x4*)(ssq + (size_t)row * 16);
    const f32x4 a = p[0], b = p[1], c = p[2], d = p[3];
    const f32x4 s = (a + b) + (c + d);
    const float t = (s[0] + s[1]) + (s[2] + s[3]);
    return rsqrtf(t * (1.f / 1024.f) + EPS);
}
DI int opaque_tid() { int t = threadIdx.x; asm volatile("" : "+v"(t)); return t; }
#define LDS_BARRIER() do { asm volatile("s_waitcnt lgkmcnt(0)" ::: "memory"); __builtin_amdgcn_s_barrier(); asm volatile("" ::: "memory"); } while (0)

namespace pg8 {
constexpr int BM = 256, BK = 64, HALF = 128, HTB = HALF * BK * 2, STAGE_BYTES = 8 * HTB, NXCD = 8, WGM = 8;
DI int lds_byte(int r, int c) { const int st = (r >> 4) * 2 + (c >> 5), rr = r & 15, cc = c & 31, ob = rr * 64 + cc * 2; return st * 1024 + (ob ^ (((ob >> 9) & 1) << 5)); }
DI void stage_rc(int b, int& R, int& C) { const int st = b / 1024, sb = b % 1024, swz = sb ^ (((sb >> 9) & 1) << 5); R = (st >> 1) * 16 + swz / 64; C = (st & 1) * 32 + (swz % 64) / 2; }
DI int perm32(int rho) { const int n = rho >> 4, i = rho & 15; return 8 * (i >> 2) + 4 * n + (i & 3); }
struct Unit { int pm, pn; };
struct Gemm { const bf16_t* A; const bf16_t* Bt; int M, N, K; };
struct StaticOrder {
    int nM, nN, nwg, G, c;
    DI void init(int M, int N, int G_, int c_) { nM = M / BM; nN = N / BM; nwg = nM * nN; G = G_; c = c_; }
    DI bool next(int i, Unit& u) const {
        const long L = (long)i * G + c; if (L >= nwg) return false;
        int wgid = (int)L; { const int q = nwg / NXCD, r = nwg % NXCD, xcd = wgid % NXCD, off = wgid / NXCD; wgid = (xcd < r ? xcd * (q + 1) : r * (q + 1) + (xcd - r) * q) + off; }
        const int nig = WGM * nN, gid = wgid / nig, fm = gid * WGM, gsz = (nM - fm) < WGM ? (nM - fm) : WGM;
        u.pm = fm + ((wgid % nig) % gsz); u.pn = (wgid % nig) / gsz; return true;
    }
};

template <class Epi>
DI void gemm_phase(LAS unsigned char* lds, const Gemm g, const StaticOrder& S, const Epi& E) {
    const int tid = opaque_tid(), wid = __builtin_amdgcn_readfirstlane(tid >> 6), lane = tid & 63, wr = wid >> 2, wc = wid & 3, fr = lane & 15, fq = lane >> 4;
    const int K = g.K, nt = K / BK;
    unsigned voffA[2], voffB[2];
#pragma unroll
    for (int i = 0; i < 2; ++i) { int R, C; stage_rc(tid * 16 + i * 8192, R, C); const int Rb = Epi::PERM ? ((R & ~31) + perm32(R & 31)) : R;
        voffA[i] = (unsigned)(R * K + C) * 2u; voffB[i] = (unsigned)(Rb * K + C) * 2u; }
    const size_t kstep = (size_t)(BK * 2);
    const size_t hstep = (size_t)HALF * K * 2;
    const size_t tstep = 2 * hstep;
    const unsigned ldsw = (unsigned)wid * 1024u;
    const int aoff = lds_byte(wr * 64 + fr, fq * 8), boff = lds_byte(wc * 32 + fr, fq * 8);
#define PG8_SA(b, h) (((b) * 2 + (h)) * HTB)
#define PG8_SB(b, h) ((4 + (b) * 2 + (h)) * HTB)
#define PG8_STAGE(bufoff, gbase, voff) do { _Pragma("unroll") for (int _i = 0; _i < 2; ++_i) \
        __builtin_amdgcn_global_load_lds((const unsigned*)((const char*)(gbase) + (voff)[_i]), (LAS unsigned*)(lds + (bufoff) + ldsw + _i * 8192), 16, 0, 0); } while (0)
#define PG8_LDA(dst, b, h) do { _Pragma("unroll") for (int m = 0; m < 4; ++m) _Pragma("unroll") for (int k = 0; k < 2; ++k) dst[m][k] = *(const LAS bf16x8*)(lds + PG8_SA(b, h) + aoff + m * 2048 + k * 1024); } while (0)
#define PG8_LDB(dst, b, h) do { _Pragma("unroll") for (int n = 0; n < 2; ++n) _Pragma("unroll") for (int k = 0; k < 2; ++k) dst[n][k] = *(const LAS bf16x8*)(lds + PG8_SB(b, h) + boff + n * 2048 + k * 1024); } while (0)
#define PG8_MMA(ai, bj, At, Bt) do { __builtin_amdgcn_s_setprio(1); _Pragma("unroll") for (int m = 0; m < 4; ++m) _Pragma("unroll") for (int n = 0; n < 2; ++n) _Pragma("unroll") for (int k = 0; k < 2; ++k) \
        acc[ai][bj][m][n] = __builtin_amdgcn_mfma_f32_16x16x32_bf16(Bt[n][k], At[m][k], acc[ai][bj][m][n], 0, 0, 0); __builtin_amdgcn_s_setprio(0); } while (0)
#define PG8_WAIT_V(n) asm volatile("s_waitcnt vmcnt(" #n ")" ::: "memory")
#define PG8_WAIT_L(n) asm volatile("s_waitcnt lgkmcnt(" #n ")" ::: "memory")
#define PG8_BAR __builtin_amdgcn_s_barrier()
#define PG8_SCHED __builtin_amdgcn_sched_barrier(0)
    Unit cur, nxt; int ui = 0;
    if (!S.next(0, cur)) return;
    f32x4 acc[2][2][4][2];
#pragma unroll
    for (int a = 0; a < 2; ++a)
#pragma unroll
        for (int b = 0; b < 2; ++b)
#pragma unroll
            for (int m = 0; m < 4; ++m)
#pragma unroll
                for (int n = 0; n < 2; ++n) acc[a][b][m][n] = (f32x4){0.f, 0.f, 0.f, 0.f};
    bf16x8 At[4][2], B0[2][2], B1[2][2];
    const char* cA = (const char*)g.A + (size_t)cur.pm * tstep; const char* cB = (const char*)g.Bt + (size_t)cur.pn * tstep;
    PG8_STAGE(PG8_SB(0, 0), cB, voffB); PG8_STAGE(PG8_SA(0, 0), cA, voffA); PG8_STAGE(PG8_SB(0, 1), cB + hstep, voffB); PG8_STAGE(PG8_SA(0, 1), cA + hstep, voffA);
    if (wr == 1) PG8_BAR;
    PG8_WAIT_V(4); PG8_BAR;
    PG8_STAGE(PG8_SB(1, 0), cB + kstep, voffB); PG8_STAGE(PG8_SA(1, 0), cA + kstep, voffA); PG8_STAGE(PG8_SB(1, 1), cB + hstep + kstep, voffB);
    PG8_WAIT_V(6); PG8_BAR;
    for (;;) {
        const bool has_next = S.next(ui + 1, nxt);
        const char* nA = has_next ? (const char*)g.A + (size_t)nxt.pm * tstep : cA; const char* nB = has_next ? (const char*)g.Bt + (size_t)nxt.pn * tstep : cB;
        for (int t = 0; t < nt; t += 2) {
            const bool last = (t == nt - 2);
            const char* a1 = cA + (size_t)(t + 1) * kstep;
            const char* a2 = last ? nA : cA + (size_t)(t + 2) * kstep; const char* b2 = last ? nB : cB + (size_t)(t + 2) * kstep;
            const char* a3 = a2 + kstep; const char* b3 = b2 + kstep;
            PG8_LDB(B0, 0, 0); PG8_SCHED; PG8_LDA(At, 0, 0); PG8_STAGE(PG8_SA(1, 1), a1 + hstep, voffA);
            PG8_WAIT_L(8); PG8_BAR; PG8_WAIT_L(0); PG8_MMA(0, 0, At, B0); PG8_BAR; PG8_SCHED;
            PG8_LDB(B1, 0, 1); PG8_STAGE(PG8_SB(0, 0), b2, voffB);
            PG8_BAR; PG8_WAIT_L(0); PG8_MMA(0, 1, At, B1); PG8_BAR;
            PG8_LDA(At, 0, 1); PG8_STAGE(PG8_SA(0, 0), a2, voffA);
            PG8_BAR; PG8_WAIT_L(0); PG8_MMA(1, 0, At, B0); PG8_BAR; PG8_SCHED;
            PG8_STAGE(PG8_SB(0, 1), b2 + hstep, voffB);
            PG8_WAIT_V(6); PG8_BAR; PG8_MMA(1, 1, At, B1); PG8_BAR;
            PG8_LDB(B0, 1, 0); PG8_SCHED; PG8_LDA(At, 1, 0); PG8_STAGE(PG8_SA(0, 1), a2 + hstep, voffA);
            PG8_WAIT_L(8); PG8_BAR; PG8_WAIT_L(0); PG8_MMA(0, 0, At, B0); PG8_BAR; PG8_SCHED;
            PG8_LDB(B1, 1, 1); PG8_STAGE(PG8_SB(1, 0), b3, voffB);
            PG8_BAR; PG8_WAIT_L(0); PG8_MMA(0, 1, At, B1); PG8_BAR;
            PG8_LDA(At, 1, 1); PG8_STAGE(PG8_SA(1, 0), a3, voffA);
            PG8_BAR; PG8_WAIT_L(0); PG8_MMA(1, 0, At, B0); PG8_BAR; PG8_SCHED;
            PG8_STAGE(PG8_SB(1, 1), b3 + hstep, voffB);
            PG8_WAIT_V(6); PG8_BAR; PG8_MMA(1, 1, At, B1); PG8_BAR;
        }
        PG8_SCHED; asm volatile("" ::: "memory");
        E(acc, cur, wr, wc, fr, fq);
        asm volatile("" ::: "memory"); PG8_SCHED;
        if (!has_next) break;
#pragma unroll
        for (int a = 0; a < 2; ++a)
#pragma unroll
            for (int b = 0; b < 2; ++b)
#pragma unroll
                for (int m = 0; m < 4; ++m)
#pragma unroll
                    for (int n = 0; n < 2; ++n) acc[a][b][m][n] = (f32x4){0.f, 0.f, 0.f, 0.f};
        cur = nxt; cA = nA; cB = nB; ++ui;
    }
    PG8_WAIT_V(0);
    if (wr == 0) PG8_BAR;
    PG8_BAR;
#undef PG8_SA
#undef PG8_SB
#undef PG8_STAGE
#undef PG8_LDA
#undef PG8_LDB
#undef PG8_MMA
#undef PG8_WAIT_V
#undef PG8_WAIT_L
#undef PG8_BAR
#undef PG8_SCHED
}
}
using pg8::Unit;

struct EpiSwiglu {
    static constexpr bool PERM = true;
    const float* ssq; const float* shw; bf16_t* act;
    DI void operator()(const f32x4 (&acc)[2][2][4][2], const Unit& u, int wr, int wc, int fr, int fq) const {
        const int mr = u.pm < 256 ? (u.pm >> 5) : 8;
        const int nb = u.pn * 256 + wc * 32 + 8 * fq;
        const int fb = u.pn * 128 + wc * 32 + 8 * fq;
        const float* sp = shw + (size_t)mr * SHW_LD + nb;
        const f32x4 sg0 = *(const f32x4*)(sp), sg1 = *(const f32x4*)(sp + 4), su0 = *(const f32x4*)(sp + 128), su1 = *(const f32x4*)(sp + 132);
#pragma unroll
        for (int ai = 0; ai < 2; ++ai)
#pragma unroll
            for (int m = 0; m < 4; ++m) {
                const int row = u.pm * 256 + ai * 128 + wr * 64 + m * 16 + fr;
                const float rs = row_rstd(ssq, row);
                const f32x4 g0 = acc[ai][0][m][0] * rs + sg0, g1 = acc[ai][0][m][1] * rs + sg1;
                const f32x4 u0 = acc[ai][1][m][0] * rs + su0, u1 = acc[ai][1][m][1] * rs + su1;
                f32x4 a0, a1;
#pragma unroll
                for (int j = 0; j < 4; ++j) { a0[j] = silu_f(g0[j]) * u0[j]; a1[j] = silu_f(g1[j]) * u1[j]; }
                *(u32x4*)(act + (size_t)row * FF + fb) = pack8(a0, a1);
            }
    }
};
template <bool WA> struct EpiRes {
    static constexpr bool PERM = true;
    const float* hin_lat; const float* hin_ctx; float* hout_lat; float* hout_ctx;
    const float* cvec; const float* gvec; const float* svec; bf16_t* Aout; float* ssq; float cmul; float pad_;
    DI void operator()(const f32x4 (&acc)[2][2][4][2], const Unit& u, int wr, int wc, int fr, int fq) const {
        const int mr = u.pm < 256 ? (u.pm >> 5) : 8;
        const int cb = u.pn * 256 + wc * 32 + 8 * fq;
        const int row0 = u.pm * 256 + wr * 64 + fr;
        const bool lat = u.pm < 256;
        const float* hi0 = lat ? hin_lat + (size_t)row0 * D : hin_ctx + (size_t)(row0 - ML) * D;
        float* ho0 = lat ? hout_lat + (size_t)row0 * D : hout_ctx + (size_t)(row0 - ML) * D;
        float ss[2][4];
#pragma unroll
        for (int ai = 0; ai < 2; ++ai)
#pragma unroll
            for (int m = 0; m < 4; ++m) ss[ai][m] = 0.f;
#pragma unroll
        for (int bj = 0; bj < 2; ++bj) {
            const int c = cb + bj * 128;
            const f32x4 cf0 = *(const f32x4*)(cvec + (size_t)mr * NMOD + c) * cmul, cf1 = *(const f32x4*)(cvec + (size_t)mr * NMOD + c + 4) * cmul;
            f32x4 gs0, gs1;
            if (WA) { gs0 = *(const f32x4*)(gvec + c) * (*(const f32x4*)(svec + (size_t)mr * NMOD + c) + 1.f); gs1 = *(const f32x4*)(gvec + c + 4) * (*(const f32x4*)(svec + (size_t)mr * NMOD + c + 4) + 1.f); }
#pragma unroll
            for (int ai = 0; ai < 2; ++ai)
#pragma unroll
                for (int m = 0; m < 4; ++m) {
                    const size_t ro = (size_t)(ai * 128 + m * 16) * D + c;
                    const f32x4 h0 = *(const f32x4*)(hi0 + ro), h1 = *(const f32x4*)(hi0 + ro + 4);
                    const f32x4 n0 = h0 + cf0 * acc[ai][bj][m][0], n1 = h1 + cf1 * acc[ai][bj][m][1];
                    *(f32x4*)(ho0 + ro) = n0; *(f32x4*)(ho0 + ro + 4) = n1;
                    ss[ai][m] += ((n0[0] * n0[0] + n0[1] * n0[1]) + (n0[2] * n0[2] + n0[3] * n0[3])) + ((n1[0] * n1[0] + n1[1] * n1[1]) + (n1[2] * n1[2] + n1[3] * n1[3]));
                    if (WA) *(u32x4*)(Aout + (size_t)(row0 + ai * 128 + m * 16) * D + c) = pack8(n0 * gs0, n1 * gs1);
                    if (m & 1) asm volatile("" ::: "memory");
                }
        }
#pragma unroll
        for (int ai = 0; ai < 2; ++ai)
#pragma unroll
            for (int m = 0; m < 4; ++m) {
                float v = ss[ai][m];
                v += __shfl_xor(v, 16); v += __shfl_xor(v, 32);
                if (fq == 0) ssq[(size_t)(row0 + ai * 128 + m * 16) * 16 + u.pn * 4 + wc] = v;
            }
    }
};
struct EpiConvIn {
    static constexpr bool PERM = true;
    const float* ssq; const float* shw; bf16_t* bg; bf16_t* z;
    DI void operator()(const f32x4 (&acc)[2][2][4][2], const Unit& u, int wr, int wc, int fr, int fq) const {
        const int mr = u.pm < 256 ? (u.pm >> 5) : 8;
        const int nb = u.pn * 256 + wc * 32 + 8 * fq;
        const float* sp = shw + (size_t)mr * SHW_LD + nb;
        const f32x4 s00 = *(const f32x4*)(sp), s01 = *(const f32x4*)(sp + 4), s10 = *(const f32x4*)(sp + 128), s11 = *(const f32x4*)(sp + 132);
        const bool isbg = u.pn < 4;
        const int ch = (u.pn - 4) * 128 + wc * 32 + 8 * fq;
#pragma unroll
        for (int ai = 0; ai < 2; ++ai)
#pragma unroll
            for (int m = 0; m < 4; ++m) {
                const int row = u.pm * 256 + ai * 128 + wr * 64 + m * 16 + fr;
                const float rs = row_rstd(ssq, row);
                const f32x4 v00 = acc[ai][0][m][0] * rs + s00, v01 = acc[ai][0][m][1] * rs + s01;
                const f32x4 v10 = acc[ai][1][m][0] * rs + s10, v11 = acc[ai][1][m][1] * rs + s11;
                if (isbg) {
                    *(u32x4*)(bg + (size_t)row * D + nb) = pack8(v00, v01);
                    *(u32x4*)(bg + (size_t)row * D + nb + 128) = pack8(v10, v11);
                } else {
                    *(u32x4*)(z + (size_t)row * D + ch) = pack8(v00 * v10, v01 * v11);
                }
            }
    }
};
struct EpiHgIn {
    static constexpr bool PERM = true;
    const float* ssq; const float* shw; const float* lb; bf16_t* q; bf16_t* v; bf16_t* lffw; bf16_t* lfbw; bf16_t* sog;
    DI void operator()(const f32x4 (&acc)[2][2][4][2], const Unit& u, int wr, int wc, int fr, int fq) const {
        const int mr = u.pm < 256 ? (u.pm >> 5) : 8;
        const int seg = u.pn >> 2;
        const int nb = u.pn * 256 + wc * 32 + 8 * fq;
        const int cc = nb - seg * 1024;
        const int row0 = u.pm * 256 + wr * 64 + fr;
        const float* sp = shw + (size_t)mr * SHW_LD + nb;
        if ((seg == 0 || seg == 4) && u.pm >= 256) return;
        float rs[2][4];
#pragma unroll
        for (int ai = 0; ai < 2; ++ai)
#pragma unroll
            for (int m = 0; m < 4; ++m) rs[ai][m] = row_rstd(ssq, row0 + ai * 128 + m * 16);
        if (seg == 2 || seg == 3) {
            bf16_t* dst = (seg == 2 ? lffw : lfbw) + (size_t)row0 * D + cc;
            const float* lbp = lb + (seg - 2) * 1024 + cc;
#pragma unroll
            for (int bj = 0; bj < 2; ++bj) {
                const f32x4 sh0 = *(const f32x4*)(sp + bj * 128), sh1 = *(const f32x4*)(sp + bj * 128 + 4);
                const f32x4 lb0 = *(const f32x4*)(lbp + bj * 128), lb1 = *(const f32x4*)(lbp + bj * 128 + 4);
#pragma unroll
                for (int ai = 0; ai < 2; ++ai)
#pragma unroll
                    for (int m = 0; m < 4; ++m) {
                        f32x4 a0 = acc[ai][bj][m][0] * rs[ai][m] + sh0, a1 = acc[ai][bj][m][1] * rs[ai][m] + sh1;
#pragma unroll
                        for (int j = 0; j < 4; ++j) {
                            a0[j] = __logf(lb0[j] + (1.f - lb0[j]) * sigmoid_f(a0[j]));
                            a1[j] = __logf(lb1[j] + (1.f - lb1[j]) * sigmoid_f(a1[j]));
                        }
                        u32x4 w; w.x = pk_f16(a0[0], a0[1]); w.y = pk_f16(a0[2], a0[3]); w.z = pk_f16(a1[0], a1[1]); w.w = pk_f16(a1[2], a1[3]);
                        *(u32x4*)(dst + (size_t)(ai * 128 + m * 16) * D + bj * 128) = w;
                    }
            }
        } else {
            bf16_t* pq = q; bf16_t* pv = v; bf16_t* ps = sog;
            asm volatile("" : "+s"(pq), "+s"(pv), "+s"(ps));
            bf16_t* dst = (seg == 0 ? pq : seg == 1 ? pv : ps) + (size_t)row0 * D + cc;
            const bool act = seg != 1;
#pragma unroll
            for (int bj = 0; bj < 2; ++bj) {
                const f32x4 sh0 = *(const f32x4*)(sp + bj * 128), sh1 = *(const f32x4*)(sp + bj * 128 + 4);
#pragma unroll
                for (int ai = 0; ai < 2; ++ai)
#pragma unroll
                    for (int m = 0; m < 4; ++m) {
                        f32x4 a0 = acc[ai][bj][m][0] * rs[ai][m] + sh0, a1 = acc[ai][bj][m][1] * rs[ai][m] + sh1;
                        if (act) {
#pragma unroll
                            for (int j = 0; j < 4; ++j) { a0[j] = silu_f(a0[j]); a1[j] = silu_f(a1[j]); }
                        }
                        *(u32x4*)(dst + (size_t)(ai * 128 + m * 16) * D + bj * 128) = pack8(a0, a1);
                    }
            }
        }
    }
};

DI void prep0(LAS unsigned char* lds, const Params& p) {
    const int tid = opaque_tid(), G = gridDim.x, bid = blockIdx.x;
    float* mods = (float*)(p.ws + OFF_MODS);
    if (bid == 0) for (int i = tid; i < 2048; i += NTHREADS) { const float l0 = p.lb_logits[i], l1 = p.lb_logits[2048 + i]; ((float*)(p.ws + OFF_LB))[i] = 1.f / (1.f + __expf(l0 - l1)); }
    {
        LAS float* sS = (LAS float*)lds;
        LAS float* red = (LAS float*)(lds + 36864);
        if (bid < 288) {
            for (int i = tid; i < 9 * 1024; i += NTHREADS) { const int mr = i >> 10, k = i & 1023; const float v = mr < 8 ? p.c[mr * 1024 + k] : p.c_ctx[k]; sS[i] = v / (1.f + __expf(-v)); }
            __syncthreads();
            for (int t = bid; t < 288; t += G) {
                const int l = t / 144, cb = t % 144, kg = tid >> 6, cl = tid & 63, col = cb * 64 + cl;
                const float* W = p.ada_w + (size_t)l * 1024 * NMOD + col;
                float a[9];
#pragma unroll
                for (int mr = 0; mr < 9; ++mr) a[mr] = 0.f;
                for (int k = kg * 128; k < kg * 128 + 128; ++k) {
                    const float w = W[(size_t)k * NMOD];
#pragma unroll
                    for (int mr = 0; mr < 9; ++mr) a[mr] += sS[mr * 1024 + k] * w;
                }
#pragma unroll
                for (int mr = 0; mr < 9; ++mr) red[(kg * 9 + mr) * 64 + cl] = a[mr];
                __syncthreads();
                for (int i = tid; i < 576; i += NTHREADS) {
                    const int mr = i >> 6, c2 = i & 63; float s = 0.f;
#pragma unroll
                    for (int k2 = 0; k2 < 8; ++k2) s += red[(k2 * 9 + mr) * 64 + c2];
                    const int cc = cb * 64 + c2;
                    mods[(size_t)(l * 9 + mr) * NMOD + cc] = s + p.ada_b[l * NMOD + cc];
                }
                __syncthreads();
            }
        }
    }
    __syncthreads();
    LAS float* tile = (LAS float*)lds;
    for (int t = bid; t < 11008; t += G) {
        const float* src; bf16_t* dst; int K, Ns, nT, kind; int tt = t;
        if (tt < 5632) { const int i = tt / 1408; tt %= 1408; src = p.w_gu + (size_t)i * 1024 * 5632; dst = (bf16_t*)(p.ws + OFF_WGU + i * SZ_WGU1); K = 1024; Ns = 5632; nT = 88; kind = 1; }
        else if (tt < 8448) { tt -= 5632; const int i = tt / 704; tt %= 704; src = p.w_dn + (size_t)i * 2816 * 1024; dst = (bf16_t*)(p.ws + OFF_WDN + i * SZ_WDN1); K = 2816; Ns = 1024; nT = 16; kind = 0; }
        else if (tt < 9216) { tt -= 8448; src = p.cw_in; dst = (bf16_t*)(p.ws + OFF_WCIN); K = 1024; Ns = 3072; nT = 48; kind = 2; }
        else if (tt < 9472) { tt -= 9216; src = p.cw_out; dst = (bf16_t*)(p.ws + OFF_WCOUT); K = 1024; Ns = 1024; nT = 16; kind = 0; }
        else if (tt < 10752) { tt -= 9472; src = p.hw_in; dst = (bf16_t*)(p.ws + OFF_WHIN); K = 1024; Ns = 5120; nT = 80; kind = 0; }
        else { tt -= 10752; src = p.hw_out; dst = (bf16_t*)(p.ws + OFF_WHOUT); K = 1024; Ns = 1024; nT = 16; kind = 0; }
        const int tk = tt / nT, tn = tt % nT, k0 = tk * 64, n0 = tn * 64;
        int sc0 = n0;
        if (kind == 1) { const int t2 = n0 >> 8, w = n0 & 255; sc0 = (w >> 7) * 2816 + t2 * 128 + (w & 127); }
        else if (kind == 2 && n0 >= 1024) { const int q = n0 - 1024, t2 = q >> 8, w = q & 255; sc0 = 1024 + (w >> 7) * 1024 + t2 * 128 + (w & 127); }
#pragma unroll
        for (int i2 = 0; i2 < 2; ++i2) {
            const int kk = (tid >> 4) + 32 * i2, c4 = (tid & 15) * 4;
            const f32x4 v = *(const f32x4*)(src + (size_t)(k0 + kk) * Ns + sc0 + c4);
            tile[kk * 65 + c4 + 0] = v[0]; tile[kk * 65 + c4 + 1] = v[1]; tile[kk * 65 + c4 + 2] = v[2]; tile[kk * 65 + c4 + 3] = v[3];
        }
        __syncthreads();
        {
            const int n = tid >> 3, k8 = (tid & 7) * 8;
            float v8[8];
#pragma unroll
            for (int i = 0; i < 8; ++i) v8[i] = tile[(k8 + i) * 65 + n];
            u32x4 o; o.x = cvt_pk_bf16(v8[0], v8[1]); o.y = cvt_pk_bf16(v8[2], v8[3]); o.z = cvt_pk_bf16(v8[4], v8[5]); o.w = cvt_pk_bf16(v8[6], v8[7]);
            *(u32x4*)(dst + (size_t)(n0 + n) * K + k0 + k8) = o;
        }
        __syncthreads();
    }
}

DI void prep1(LAS unsigned char* lds, const Params& p) {
    const int tid = opaque_tid(), G = gridDim.x, bid = blockIdx.x, wave = tid >> 6, lane = tid & 63;
    const float* mods = (const float*)(p.ws + OFF_MODS);
    float* shw = (float*)(p.ws + OFF_SHW);
    LAS float* sh = (LAS float*)lds;
    for (int sl = 0; sl < 6; ++sl) {
        const int l = sl / 3, j = sl % 3;
        const float* mv = mods + (size_t)l * 9 * NMOD + (3 * j) * 1024;
        for (int i = tid; i < 9216; i += NTHREADS) { const int mr = i >> 10, k = i & 1023; sh[i] = mv[(size_t)mr * NMOD + k]; }
        __syncthreads();
        const bf16_t* Wt; int N;
        if (sl == 0) { Wt = (const bf16_t*)(p.ws + OFF_WGU); N = 5632; }
        else if (sl == 1) { Wt = (const bf16_t*)(p.ws + OFF_WCIN); N = 3072; }
        else if (sl == 2) { Wt = (const bf16_t*)(p.ws + OFF_WGU + SZ_WGU1); N = 5632; }
        else if (sl == 3) { Wt = (const bf16_t*)(p.ws + OFF_WGU + 2 * SZ_WGU1); N = 5632; }
        else if (sl == 4) { Wt = (const bf16_t*)(p.ws + OFF_WHIN); N = 5120; }
        else { Wt = (const bf16_t*)(p.ws + OFF_WGU + 3 * SZ_WGU1); N = 5632; }
        for (int n = bid * 8 + wave; n < N; n += G * 8) {
            const u32x4* wp = (const u32x4*)(Wt + (size_t)n * 1024 + lane * 16);
            const u32x4 w0 = wp[0], w1 = wp[1];
            float wf[16];
#pragma unroll
            for (int i = 0; i < 4; ++i) { wf[2 * i] = bf_lo(w0[i]); wf[2 * i + 1] = bf_hi(w0[i]); wf[8 + 2 * i] = bf_lo(w1[i]); wf[8 + 2 * i + 1] = bf_hi(w1[i]); }
            float res = 0.f;
#pragma unroll
            for (int mr = 0; mr < 9; ++mr) {
                const LAS f32x4* sp = (const LAS f32x4*)(sh + mr * 1024 + lane * 16);
                float a = 0.f;
#pragma unroll
                for (int q4 = 0; q4 < 4; ++q4) { const f32x4 s = sp[q4]; a += s[0] * wf[4 * q4] + s[1] * wf[4 * q4 + 1] + s[2] * wf[4 * q4 + 2] + s[3] * wf[4 * q4 + 3]; }
#pragma unroll
                for (int off = 32; off >= 1; off >>= 1) a += __shfl_xor(a, off);
                if (lane == mr) res = a;
            }
            if (lane < 9) shw[(size_t)(sl * 9 + lane) * SHW_LD + n] = res;
        }
        __syncthreads();
    }
    bf16_t* A0 = (bf16_t*)(p.ws + OFF_S0);
    float* ssq = (float*)(p.ws + OFF_SSQ);
    for (int r = bid * 8 + wave; r < MT; r += G * 8) {
        const int mr = r < ML ? (r >> 13) : 8;
        const float* xr = r < ML ? p.x + (size_t)r * D : p.ctx + (size_t)(r - ML) * D;
        const float* gp = p.norm_g + lane * 16;
        const float* sc = mods + (size_t)mr * NMOD + 1024 + lane * 16;
        float ss = 0.f; f32x4 a[4];
#pragma unroll
        for (int q4 = 0; q4 < 4; ++q4) {
            const f32x4 xv = *(const f32x4*)(xr + lane * 16 + 4 * q4), gv = *(const f32x4*)(gp + 4 * q4), sv = *(const f32x4*)(sc + 4 * q4);
            ss += (xv[0] * xv[0] + xv[1] * xv[1]) + (xv[2] * xv[2] + xv[3] * xv[3]);
            a[q4] = xv * gv * (sv + 1.f);
        }
#pragma unroll
        for (int off = 32; off >= 1; off >>= 1) ss += __shfl_xor(ss, off);
        u32x4* op = (u32x4*)(A0 + (size_t)r * D + lane * 16);
        op[0] = pack8(a[0], a[1]); op[1] = pack8(a[2], a[3]);
        if (lane < 16) ssq[(size_t)r * 16 + lane] = lane == 0 ? ss : 0.f;
    }
}

DI void unpack8(const u32x4 w, float* f) {
#pragma unroll
    for (int i = 0; i < 4; ++i) { f[2 * i] = bf_lo(w[i]); f[2 * i + 1] = bf_hi(w[i]); }
}

DI void conv_phase(const Params& p) {
    const int tid = opaque_tid(), G = gridDim.x, bid = blockIdx.x, wave = tid >> 6, lane = tid & 63;
    const bf16_t* bg = (const bf16_t*)(p.ws + OFF_S1); const bf16_t* z = (const bf16_t*)(p.ws + OFF_S2); bf16_t* U = (bf16_t*)(p.ws + OFF_S3);
    const int ch0 = lane * 16;
    float w0[16], w1[16], w2[16];
#pragma unroll
    for (int i = 0; i < 16; ++i) { w0[i] = p.cw[ch0 + i]; w1[i] = p.cw[1024 + ch0 + i]; w2[i] = p.cw[2048 + ch0 + i]; }
    for (int r = bid * 8 + wave; r < MT; r += G * 8) {
        bool hp, hn; int st;
        if (r < ML) {
            const int t = r & 8191, col = t & 63, ri = t >> 6;
            if (lane < 32) { hp = col > 0; hn = col < 63; st = 1; } else { hp = ri > 0; hn = ri < 127; st = 64; }
        } else { const int tc = (r - ML) & 255; hp = tc > 0; hn = tc < 255; st = 1; }
#pragma unroll
        for (int hf = 0; hf < 2; ++hf) {
            const size_t o = (size_t)r * D + ch0 + hf * 8;
            const u32x4 zero = {0u, 0u, 0u, 0u};
            const u32x4 zp = hp ? *(const u32x4*)(z + o - (size_t)st * D) : zero;
            const u32x4 zc = *(const u32x4*)(z + o);
            const u32x4 zn = hn ? *(const u32x4*)(z + o + (size_t)st * D) : zero;
            const u32x4 bv = *(const u32x4*)(bg + o);
            float fp[8], fc[8], fn[8], fb[8], r8[8];
            unpack8(zp, fp); unpack8(zc, fc); unpack8(zn, fn); unpack8(bv, fb);
#pragma unroll
            for (int i = 0; i < 8; ++i) r8[i] = fb[i] * (w0[hf * 8 + i] * fp[i] + w1[hf * 8 + i] * fc[i] + w2[hf * 8 + i] * fn[i]);
            u32x4 ov; ov.x = cvt_pk_bf16(r8[0], r8[1]); ov.y = cvt_pk_bf16(r8[2], r8[3]); ov.z = cvt_pk_bf16(r8[4], r8[5]); ov.w = cvt_pk_bf16(r8[6], r8[7]);
            *(u32x4*)(U + o) = ov;
        }
    }
}

DI void gate_phase(const Params& p) {
    const int tid = opaque_tid(), G = gridDim.x, bid = blockIdx.x, wave = tid >> 6, lane = tid & 63;
    bf16_t* X = (bf16_t*)(p.ws + OFF_S0); const bf16_t* Y = (const bf16_t*)(p.ws + OFF_S6); const bf16_t* sog = (const bf16_t*)(p.ws + OFF_S5);
    const int c0 = lane * 16;
    float gn[16];
#pragma unroll
    for (int i = 0; i < 16; ++i) gn[i] = p.gnorm[c0 + i];
    for (int r = bid * 8 + wave; r < ML; r += G * 8) {
        const size_t o = (size_t)r * D + c0;
        float ov[16], sv[16];
        {
            const u32x4 x0 = *(const u32x4*)(X + o), x1 = *(const u32x4*)(X + o + 8), y0 = *(const u32x4*)(Y + o), y1 = *(const u32x4*)(Y + o + 8);
            float a[8], b[8];
            unpack8(x0, a); unpack8(y0, b);
#pragma unroll
            for (int i = 0; i < 8; ++i) ov[i] = a[i] + b[i];
            unpack8(x1, a); unpack8(y1, b);
#pragma unroll
            for (int i = 0; i < 8; ++i) ov[8 + i] = a[i] + b[i];
            const u32x4 s0 = *(const u32x4*)(sog + o), s1 = *(const u32x4*)(sog + o + 8);
            unpack8(s0, sv); unpack8(s1, sv + 8);
        }
        float ss = 0.f;
#pragma unroll
        for (int i = 0; i < 16; ++i) ss += ov[i] * ov[i];
        ss += __shfl_xor(ss, 1); ss += __shfl_xor(ss, 2); ss += __shfl_xor(ss, 4);
        const float rs = rsqrtf(ss * (1.f / 128.f) + EPS);
        float r16[16];
#pragma unroll
        for (int i = 0; i < 16; ++i) r16[i] = ov[i] * rs * gn[i] * sv[i];
        u32x4 o0, o1;
        o0.x = cvt_pk_bf16(r16[0], r16[1]); o0.y = cvt_pk_bf16(r16[2], r16[3]); o0.z = cvt_pk_bf16(r16[4], r16[5]); o0.w = cvt_pk_bf16(r16[6], r16[7]);
        o1.x = cvt_pk_bf16(r16[8], r16[9]); o1.y = cvt_pk_bf16(r16[10], r16[11]); o1.z = cvt_pk_bf16(r16[12], r16[13]); o1.w = cvt_pk_bf16(r16[14], r16[15]);
        *(u32x4*)(X + o) = o0; *(u32x4*)(X + o + 8) = o1;
    }
}

DI void final_phase(const Params& p) {
    const int tid = opaque_tid(), G = gridDim.x, bid = blockIdx.x, wave = tid >> 6, lane = tid & 63;
    const float* ssq = (const float*)(p.ws + OFF_SSQ);
    f32x4 g[4];
#pragma unroll
    for (int q4 = 0; q4 < 4; ++q4) g[q4] = *(const f32x4*)(p.final_g + q4 * 256 + lane * 4);
    for (int r = bid * 8 + wave; r < ML; r += G * 8) {
        const float rs = row_rstd(ssq, r);
        float* hp = p.out + (size_t)r * D + lane * 4;
#pragma unroll
        for (int q4 = 0; q4 < 4; ++q4) { const f32x4 v = *(const f32x4*)(hp + q4 * 256); *(f32x4*)(hp + q4 * 256) = v * rs * g[q4]; }
    }
}

DI void scan_phase(LAS unsigned char* lds, const Params& p) {
    constexpr int QSTR = 272, SSTR = 144;
    constexpr int O_QT = 0, O_KT = O_QT + 64 * QSTR, O_KDT = O_KT + 64 * QSTR, O_VT = O_KDT + 128 * SSTR, O_ATT = O_VT + 64 * SSTR, O_ST = O_ATT + 64 * SSTR,
                  O_SEG = O_ST + 2 * 64 * QSTR, O_DEC = O_SEG + 2048;
    static_assert(O_DEC + 512 <= 131072, "scan LDS");
    const int tid = opaque_tid(), wv = __builtin_amdgcn_readfirstlane(tid >> 6), lane = tid & 63, fr = lane & 15, fq = lane >> 4;
    const int seg = tid >> 7, d = tid & 127;
    const int ve = tid & 63, vs = tid >> 6;
    const bf16_t* Qb = (const bf16_t*)(p.ws + OFF_S4); const bf16_t* Vb = (const bf16_t*)(p.ws + OFF_S1);
    LAS float* segtot = (LAS float*)(lds + O_SEG); LAS float* dec = (LAS float*)(lds + O_DEC);
    for (int w = blockIdx.x; w < 256; w += gridDim.x) {
        const int xx = w & 7, yy = w >> 3, pair = xx * 8 + (yy >> 2), sub = yy & 3, dir = sub & 1, eh = sub >> 1, b = pair >> 3, h = pair & 7;
        const _Float16* LF = (const _Float16*)(p.ws + (dir ? OFF_S3 : OFF_S2));
        bf16_t* Ob = (bf16_t*)(p.ws + (dir ? OFF_S6 : OFF_S0));
        const int colq = h * 128 + d, colv = h * 128 + eh * 64 + ve;
        f32x4 Sacc[4];
#pragma unroll
        for (int i = 0; i < 4; ++i) Sacc[i] = (f32x4){0.f, 0.f, 0.f, 0.f};
        for (int i = tid; i < 64 * QSTR / 4; i += NTHREADS) ((LAS unsigned*)(lds + O_ST))[i] = 0u;
        auto chunk_base = [&](int c) -> int {
            if (c < 4) return ML + b * 256 + (dir ? (3 - c) : c) * 64;
            return b * 8192 + (dir ? (127 - (c - 4)) : (c - 4)) * 64;
        };
        _Float16 lfr[16]; bf16_t qr[16]; bf16_t vr[8];
        {
            const int base = chunk_base(0);
#pragma unroll
            for (int i = 0; i < 16; ++i) { const int j = seg * 16 + i; const int row = base + (dir ? 63 - j : j); lfr[i] = LF[(size_t)row * D + colq]; qr[i] = 0; }
#pragma unroll
            for (int i = 0; i < 8; ++i) { const int j = vs * 8 + i; const int row = base + (dir ? 63 - j : j); vr[i] = Vb[(size_t)row * D + colv]; }
        }
        LDS_BARRIER();
        for (int c = 0; c < 132; ++c) {
            const bool lat = c >= 4;
            const int base = chunk_base(c);
            float lf[16], qf[16], vf[8];
#pragma unroll
            for (int i = 0; i < 16; ++i) { lf[i] = (float)lfr[i]; qf[i] = __uint_as_float((unsigned)qr[i] << 16); }
#pragma unroll
            for (int i = 0; i < 8; ++i) vf[i] = __uint_as_float((unsigned)vr[i] << 16);
            if (c + 1 < 132) {
                const int nb = chunk_base(c + 1); const bool nlat = (c + 1) >= 4;
#pragma unroll
                for (int i = 0; i < 16; ++i) { const int j = seg * 16 + i; const int row = nb + (dir ? 63 - j : j); lfr[i] = LF[(size_t)row * D + colq]; qr[i] = nlat ? Qb[(size_t)row * D + colq] : (bf16_t)0; }
#pragma unroll
                for (int i = 0; i < 8; ++i) { const int j = vs * 8 + i; const int row = nb + (dir ? 63 - j : j); vr[i] = Vb[(size_t)row * D + colv]; }
            }
            float cs[16]; float g = 0.f;
#pragma unroll
            for (int i = 0; i < 16; ++i) { g += lf[i]; cs[i] = g; }
            segtot[seg * 128 + d] = g;
            LDS_BARRIER();
            float pre = 0.f, tot = 0.f;
#pragma unroll
            for (int s4 = 0; s4 < 4; ++s4) { const float t = segtot[s4 * 128 + d]; tot += t; pre += (s4 < seg) ? t : 0.f; }
            const float etot = __expf(tot);
            {
                float kd[16];
#pragma unroll
                for (int i = 0; i < 16; ++i) {
                    const int j = seg * 16 + i;
                    const float gi = pre + cs[i];
                    const float kk = 1.f - __expf(lf[i]);
                    const float eg = __expf(gi), ieg = __builtin_amdgcn_rcpf(eg);
                    const float qt = qf[i] * eg, kt = kk * ieg;
                    kd[i] = kt * etot;
                    *(LAS bf16_t*)(lds + O_QT + j * QSTR + d * 2) = (bf16_t)(cvt_pk_bf16(qt, 0.f) & 0xffffu);
                    *(LAS bf16_t*)(lds + O_KT + j * QSTR + d * 2) = (bf16_t)(cvt_pk_bf16(kt, 0.f) & 0xffffu);
                }
                u32x4 k0, k1;
                k0.x = cvt_pk_bf16(kd[0], kd[1]); k0.y = cvt_pk_bf16(kd[2], kd[3]); k0.z = cvt_pk_bf16(kd[4], kd[5]); k0.w = cvt_pk_bf16(kd[6], kd[7]);
                k1.x = cvt_pk_bf16(kd[8], kd[9]); k1.y = cvt_pk_bf16(kd[10], kd[11]); k1.z = cvt_pk_bf16(kd[12], kd[13]); k1.w = cvt_pk_bf16(kd[14], kd[15]);
                *(LAS u32x4*)(lds + O_KDT + d * SSTR + seg * 32) = k0;
                *(LAS u32x4*)(lds + O_KDT + d * SSTR + seg * 32 + 16) = k1;
                if (seg == 0) dec[d] = etot;
                u32x4 vv; vv.x = cvt_pk_bf16(vf[0], vf[1]); vv.y = cvt_pk_bf16(vf[2], vf[3]); vv.z = cvt_pk_bf16(vf[4], vf[5]); vv.w = cvt_pk_bf16(vf[6], vf[7]);
                *(LAS u32x4*)(lds + O_VT + ve * SSTR + vs * 16) = vv;
            }
            LDS_BARRIER();
            const int cur = c & 1, nxt = cur ^ 1;
            if (lat) {
#pragma unroll
                for (int rep = 0; rep < 2; ++rep) {
                    const int idx = wv + rep * 8, ti = idx >> 2, si = idx & 3;
                    f32x4 cacc = {0.f, 0.f, 0.f, 0.f};
                    if (si <= ti) {
#pragma unroll
                        for (int kk = 0; kk < 4; ++kk) {
                            const bf16x8 a = *(const LAS bf16x8*)(lds + O_KT + (16 * si + fr) * QSTR + (32 * kk + 8 * fq) * 2);
                            const bf16x8 bq = *(const LAS bf16x8*)(lds + O_QT + (16 * ti + fr) * QSTR + (32 * kk + 8 * fq) * 2);
                            cacc = __builtin_amdgcn_mfma_f32_16x16x32_bf16(a, bq, cacc, 0, 0, 0);
                        }
                        const int t = 16 * ti + fr, s0 = 16 * si + 4 * fq;
#pragma unroll
                        for (int j = 0; j < 4; ++j) cacc[j] = (s0 + j <= t) ? cacc[j] : 0.f;
                    }
                    u32x2 wv2; wv2.x = cvt_pk_bf16(cacc[0], cacc[1]); wv2.y = cvt_pk_bf16(cacc[2], cacc[3]);
                    *(LAS u32x2*)(lds + O_ATT + (16 * ti + fr) * SSTR + (16 * si + 4 * fq) * 2) = wv2;
                }
            }
            {
                const f32x4 d4 = *(const LAS f32x4*)(lds + O_DEC + (16 * wv + 4 * fq) * 4);
#pragma unroll
                for (int ei = 0; ei < 4; ++ei) {
                    Sacc[ei] = Sacc[ei] * d4;
#pragma unroll
                    for (int kk = 0; kk < 2; ++kk) {
                        const bf16x8 a = *(const LAS bf16x8*)(lds + O_KDT + (16 * wv + fr) * SSTR + (32 * kk + 8 * fq) * 2);
                        const bf16x8 bb = *(const LAS bf16x8*)(lds + O_VT + (16 * ei + fr) * SSTR + (32 * kk + 8 * fq) * 2);
                        Sacc[ei] = __builtin_amdgcn_mfma_f32_16x16x32_bf16(a, bb, Sacc[ei], 0, 0, 0);
                    }
                    u32x2 sw; sw.x = cvt_pk_bf16(Sacc[ei][0], Sacc[ei][1]); sw.y = cvt_pk_bf16(Sacc[ei][2], Sacc[ei][3]);
                    *(LAS u32x2*)(lds + O_ST + nxt * 64 * QSTR + (16 * ei + fr) * QSTR + (16 * wv + 4 * fq) * 2) = sw;
                }
            }
            LDS_BARRIER();
            if (lat) {
                const int ti = wv >> 1;
#pragma unroll
                for (int rep = 0; rep < 2; ++rep) {
                    const int ei = (wv & 1) * 2 + rep;
                    f32x4 oacc = {0.f, 0.f, 0.f, 0.f};
#pragma unroll
                    for (int kk = 0; kk < 2; ++kk) {
                        const bf16x8 a = *(const LAS bf16x8*)(lds + O_VT + (16 * ei + fr) * SSTR + (32 * kk + 8 * fq) * 2);
                        const bf16x8 bb = *(const LAS bf16x8*)(lds + O_ATT + (16 * ti + fr) * SSTR + (32 * kk + 8 * fq) * 2);
                        oacc = __builtin_amdgcn_mfma_f32_16x16x32_bf16(a, bb, oacc, 0, 0, 0);
                    }
#pragma unroll
                    for (int kk = 0; kk < 4; ++kk) {
                        const bf16x8 a = *(const LAS bf16x8*)(lds + O_ST + cur * 64 * QSTR + (16 * ei + fr) * QSTR + (32 * kk + 8 * fq) * 2);
                        const bf16x8 bb = *(const LAS bf16x8*)(lds + O_QT + (16 * ti + fr) * QSTR + (32 * kk + 8 * fq) * 2);
                        oacc = __builtin_amdgcn_mfma_f32_16x16x32_bf16(a, bb, oacc, 0, 0, 0);
                    }
                    const int t = 16 * ti + fr; const int row = base + (dir ? 63 - t : t);
                    u32x2 ow; ow.x = cvt_pk_bf16(oacc[0], oacc[1]); ow.y = cvt_pk_bf16(oacc[2], oacc[3]);
                    *(u32x2*)(Ob + (size_t)row * D + h * 128 + eh * 64 + 16 * ei + 4 * fq) = ow;
                }
            }
            LDS_BARRIER();
        }
    }
}

__global__ void __launch_bounds__(NTHREADS, 2) mega(Params p) {
    extern __shared__ __attribute__((aligned(16))) unsigned char lds_raw[];
    LAS unsigned char* lds = (LAS unsigned char*)lds_raw;
    cg::grid_group grid = cg::this_grid();
    unsigned char* ws = p.ws;
    const float* mods = (const float*)(ws + OFF_MODS);
    const float* shw = (const float*)(ws + OFF_SHW);
    float* ssq = (float*)(ws + OFF_SSQ);
    float* hctx = (float*)(ws + OFF_HCTX);
    const int G = gridDim.x, bid = blockIdx.x;
    for (int ph = p.ph_lo; ph < p.ph_hi; ++ph) {
        if (PHON(0) && ph == 0) prep0(lds, p);
        else if (PHON(1) && ph == 1) prep1(lds, p);
        else if (PHON(2) && (ph == 2 || ph == 7 || ph == 9 || ph == 15)) {
            const int fi = ph == 2 ? 0 : ph == 7 ? 1 : ph == 9 ? 2 : 3;
            const int sl = ph == 2 ? 0 : ph == 7 ? 2 : ph == 9 ? 3 : 5;
            const int M = ph == 15 ? ML : MT;
            const bf16_t* A = (const bf16_t*)(ws + (ph == 15 ? OFF_S4 : OFF_S0));
            pg8::Gemm g{A, (const bf16_t*)(ws + OFF_WGU + fi * SZ_WGU1), M, 2 * FF, D};
            pg8::StaticOrder S; S.init(M, 2 * FF, G, bid);
            EpiSwiglu E{ssq, shw + (size_t)sl * 9 * SHW_LD, (bf16_t*)(ws + OFF_S1)};
            pg8::gemm_phase<EpiSwiglu>(lds, g, S, E);
        } else if (PHON(3) && (ph == 3 || ph == 8 || ph == 10 || ph == 6 || ph == 14)) {
            const bool ffn = (ph == 3 || ph == 8 || ph == 10);
            const int fi = ph == 3 ? 0 : ph == 8 ? 1 : 2;
            const int sl = ph == 3 ? 0 : ph == 6 ? 1 : ph == 8 ? 2 : ph == 10 ? 3 : 4;
            const int l = sl / 3, j = sl % 3, sn = sl + 1, ln = sn / 3, jn = sn % 3;
            const int M = ph == 14 ? ML : MT;
            const bf16_t* A = ffn ? (const bf16_t*)(ws + OFF_S1) : ph == 6 ? (const bf16_t*)(ws + OFF_S3) : (const bf16_t*)(ws + OFF_S0);
            const bf16_t* Bt = ffn ? (const bf16_t*)(ws + OFF_WDN + fi * SZ_WDN1) : ph == 6 ? (const bf16_t*)(ws + OFF_WCOUT) : (const bf16_t*)(ws + OFF_WHOUT);
            pg8::Gemm g{A, Bt, M, D, ffn ? FF : D};
            pg8::StaticOrder S; S.init(M, D, G, bid);
            const EpiRes<true> E{ph == 3 ? p.x : p.out, ph == 3 ? p.ctx : hctx, p.out, hctx,
                                 mods + (size_t)l * 9 * NMOD + (3 * j + 2) * 1024, p.norm_g + (ln * 3 + jn) * 1024, mods + (size_t)ln * 9 * NMOD + (3 * jn + 1) * 1024,
                                 (bf16_t*)(ws + (ph == 14 ? OFF_S4 : OFF_S0)), ssq, ffn ? 0.5f : 1.0f, 0.f};
            pg8::gemm_phase<EpiRes<true>>(lds, g, S, E);
        } else if (PHON(16) && ph == 16) {
            pg8::Gemm g{(const bf16_t*)(ws + OFF_S1), (const bf16_t*)(ws + OFF_WDN + 3 * SZ_WDN1), ML, D, FF};
            pg8::StaticOrder S; S.init(ML, D, G, bid);
            const EpiRes<false> E{p.out, hctx, p.out, hctx, mods + (size_t)1 * 9 * NMOD + 8 * 1024, p.norm_g, mods, nullptr, ssq, 0.5f, 0.f};
            pg8::gemm_phase<EpiRes<false>>(lds, g, S, E);
        } else if (PHON(4) && ph == 4) {
            pg8::Gemm g{(const bf16_t*)(ws + OFF_S0), (const bf16_t*)(ws + OFF_WCIN), MT, 3 * D, D};
            pg8::StaticOrder S; S.init(MT, 3 * D, G, bid);
            EpiConvIn E{ssq, shw + (size_t)1 * 9 * SHW_LD, (bf16_t*)(ws + OFF_S1), (bf16_t*)(ws + OFF_S2)};
            pg8::gemm_phase<EpiConvIn>(lds, g, S, E);
        } else if (PHON(5) && ph == 5) conv_phase(p);
        else if (PHON(11) && ph == 11) {
            pg8::Gemm g{(const bf16_t*)(ws + OFF_S0), (const bf16_t*)(ws + OFF_WHIN), MT, 5 * D, D};
            pg8::StaticOrder S; S.init(MT, 5 * D, G, bid);
            EpiHgIn E{ssq, shw + (size_t)4 * 9 * SHW_LD, (const float*)(ws + OFF_LB), (bf16_t*)(ws + OFF_S4), (bf16_t*)(ws + OFF_S1), (bf16_t*)(ws + OFF_S2), (bf16_t*)(ws + OFF_S3), (bf16_t*)(ws + OFF_S5)};
            pg8::gemm_phase<EpiHgIn>(lds, g, S, E);
        } else if (PHON(12) && ph == 12) scan_phase(lds, p);
        else if (PHON(13) && ph == 13) gate_phase(p);
        else if (PHON(17) && ph == 17) final_phase(p);
        if (ph + 1 < p.ph_hi) grid.sync();
    }
}

extern "C" void kernel_launch(void* const* d_in, const int* in_sizes, int n_in, void* d_out, int out_size, void* d_ws, size_t ws_size, hipStream_t stream) {
    static int grid = 0;
    if (grid == 0) {
        if (n_in != 17 || ws_size < WS_END || out_size != ML * D) { fprintf(stderr, "kernel_launch: unexpected shapes (n_in %d, ws %zu < %zu?, out %d)\n", n_in, ws_size, (size_t)WS_END, out_size); grid = -1; return; }
        int dev = 0, cus = 0, per_cu = 0;
        hipGetDevice(&dev);
        hipDeviceGetAttribute(&cus, hipDeviceAttributeMultiprocessorCount, dev);
        if (hipFuncSetAttribute((const void*)mega, hipFuncAttributeMaxDynamicSharedMemorySize, LDS_BYTES) != hipSuccess) { fprintf(stderr, "kernel_launch: hipFuncSetAttribute failed\n"); grid = -1; return; }
        if (hipOccupancyMaxActiveBlocksPerMultiprocessor(&per_cu, (const void*)mega, NTHREADS, LDS_BYTES) != hipSuccess || per_cu < 1) { fprintf(stderr, "kernel_launch: occupancy query gives %d\n", per_cu); per_cu = 1; }
        (void)hipGetLastError();
        grid = cus * 1;
    }
    if (grid < 0) return;
    Params p{};
    const float** pp = (const float**)&p;
    for (int i = 0; i < 17; ++i) pp[i] = (const float*)d_in[i];
    p.out = (float*)d_out; p.ws = (unsigned char*)d_ws; p.ph_lo = 0; p.ph_hi = NPHASES;
    void* args[] = {&p};
    hipError_t e = hipLaunchCooperativeKernel((const void*)mega, dim3(grid), dim3(NTHREADS), args, LDS_BYTES, stream);
    if (e != hipSuccess) fprintf(stderr, "cooperative launch failed: %s (grid %d)\n", hipGetErrorString(e), grid);
}
```

```cpp
#include <hip/hip_runtime.h>
#include <hip/hip_cooperative_groups.h>
#include <cstdio>
namespace cg = cooperative_groups;

#define LAS __attribute__((address_space(3)))
#define DI __device__ __forceinline__
typedef unsigned short bf16_t;
typedef short bf16x8 __attribute__((ext_vector_type(8)));
typedef float f32x4 __attribute__((ext_vector_type(4)));
typedef unsigned u32x4 __attribute__((ext_vector_type(4)));
typedef unsigned u32x2 __attribute__((ext_vector_type(2)));

constexpr int D = 1024, NB = 8, SEQ = 8192, LC = 256, FF = 2816;
constexpr int ML = NB * SEQ;
constexpr int MC = NB * LC;
constexpr int MT = ML + MC;
constexpr int NMOD = 9 * D;
constexpr int SHW_LD = 5632;
constexpr float EPS = 1e-6f;
constexpr int NTHREADS = 512;
constexpr int LDS_BYTES = 139264 + 1024;
constexpr int NPHASES = 18;
#ifndef PHSEL
#define PHSEL 0x3FFFF
#endif
#define PHON(k) (((PHSEL) >> (k)) & 1)

constexpr size_t R2 = (size_t)MT * D * 2, L2B = (size_t)ML * D * 2;
constexpr size_t SZ_WGU1 = (size_t)2 * FF * D * 2, SZ_WDN1 = (size_t)D * FF * 2;
constexpr size_t OFF_WGU = 0;
constexpr size_t OFF_WDN = OFF_WGU + 4 * SZ_WGU1;
constexpr size_t OFF_WCIN = OFF_WDN + 4 * SZ_WDN1;
constexpr size_t OFF_WCOUT = OFF_WCIN + (size_t)3 * D * D * 2;
constexpr size_t OFF_WHIN = OFF_WCOUT + (size_t)D * D * 2;
constexpr size_t OFF_WHOUT = OFF_WHIN + (size_t)5 * D * D * 2;
constexpr size_t OFF_MODS = OFF_WHOUT + (size_t)D * D * 2;
constexpr size_t OFF_SHW = OFF_MODS + (size_t)2 * 9 * NMOD * 4;
constexpr size_t OFF_LB = OFF_SHW + (size_t)6 * 9 * SHW_LD * 4;
constexpr size_t OFF_DBG = OFF_LB + 2 * 1024 * 4;
constexpr size_t OFF_BAR = OFF_DBG + 256;
constexpr size_t OFF_SSQ = OFF_BAR + 16384;
constexpr size_t OFF_HCTX = OFF_SSQ + (size_t)MT * 16 * 4;
constexpr size_t OFF_S0 = ((OFF_HCTX + (size_t)MC * D * 4 + 4095) / 4096) * 4096;
constexpr size_t OFF_S1 = OFF_S0 + R2;
constexpr size_t OFF_S2 = OFF_S1 + R2;
constexpr size_t OFF_S3 = OFF_S2 + R2;
constexpr size_t OFF_S4 = OFF_S3 + R2;
constexpr size_t OFF_S5 = OFF_S4 + L2B;
constexpr size_t OFF_S6 = OFF_S5 + L2B;
constexpr size_t WS_END = OFF_S6 + L2B;
static_assert((size_t)MT * FF * 2 <= 3 * R2, "act fits in S1..S3");
static_assert(WS_END <= (size_t)1073741824, "workspace budget");

struct Params {
    const float *x, *c, *ctx, *c_ctx, *ada_w, *ada_b, *norm_g, *w_gu, *w_dn, *cw_in, *cw, *cw_out, *hw_in, *lb_logits, *gnorm, *hw_out, *final_g;
    float* out; unsigned char* ws; int ph_lo, ph_hi;
};

DI unsigned cvt_pk_bf16(float lo, float hi) { typedef __bf16 bf2 __attribute__((ext_vector_type(2))); bf2 v = {(__bf16)lo, (__bf16)hi}; return __builtin_bit_cast(unsigned, v); }
DI unsigned pk_f16(float a, float b) { typedef _Float16 h2 __attribute__((ext_vector_type(2))); h2 v = {(_Float16)a, (_Float16)b}; return __builtin_bit_cast(unsigned, v); }
DI float bf_lo(unsigned u) { return __uint_as_float(u << 16); }
DI float bf_hi(unsigned u) { return __uint_as_float(u & 0xffff0000u); }
DI float silu_f(float x) { return x * __builtin_amdgcn_rcpf(1.f + __expf(-x)); }
DI float sigmoid_f(float x) { return __builtin_amdgcn_rcpf(1.f + __expf(-x)); }
DI u32x4 pack8(const f32x4 a, const f32x4 b) { u32x4 w; w.x = cvt_pk_bf16(a[0], a[1]); w.y = cvt_pk_bf16(a[2], a[3]); w.z = cvt_pk_bf16(b[0], b[1]); w.w = cvt_pk_bf16(b[2], b[3]); return w; }
DI float row_rstd(const float* ssq, int row) {
    const f32x4* p = (const f32x4*)(ssq + (size_t)row * 16);
    const f32x4 a = p[0], b = p[1], c = p[2], d = p[3];
    const f32x4 s = (a + b) + (c + d);
    const float t = (s[0] + s[1]) + (s[2] + s[3]);
    return rsqrtf(t * (1.f / 1024.f) + EPS);
}
DI void rows_rstd(const float* ssq, int row0, int fq, float (&rs)[2][4]) {
    f32x4 v[2][4];
#pragma unroll
    for (int ai = 0; ai < 2; ++ai)
#pragma unroll
        for (int m = 0; m < 4; ++m) v[ai][m] = *(const f32x4*)(ssq + (size_t)(row0 + ai * 128 + m * 16) * 16 + 4 * fq);
#pragma unroll
    for (int ai = 0; ai < 2; ++ai)
#pragma unroll
        for (int m = 0; m < 4; ++m) {
            float t = (v[ai][m][0] + v[ai][m][1]) + (v[ai][m][2] + v[ai][m][3]);
            t += __shfl_xor(t, 16); t += __shfl_xor(t, 32);
            rs[ai][m] = rsqrtf(t * (1.f / 1024.f) + EPS);
        }
}
DI int opaque_tid(int wave_id) { unsigned z = 0u; asm volatile("" : "+v"(z)); return (int)__builtin_amdgcn_mbcnt_hi(~0u, __builtin_amdgcn_mbcnt_lo(~0u, z)) + wave_id * 64; }
#define LDS_BARRIER() do { asm volatile("s_waitcnt lgkmcnt(0)" ::: "memory"); __builtin_amdgcn_s_barrier(); asm volatile("" ::: "memory"); } while (0)

namespace pg8 {
constexpr int BM = 256, BK = 64, HALF = 128, HTB = HALF * BK * 2, STAGE_BYTES = 8 * HTB, NXCD = 8, WGM = 8;
DI int lds_byte(int r, int c) { const int st = (r >> 4) * 2 + (c >> 5), rr = r & 15, cc = c & 31, ob = rr * 64 + cc * 2; return st * 1024 + (ob ^ (((ob >> 9) & 1) << 5)); }
DI void stage_rc(int b, int& R, int& C) { const int st = b / 1024, sb = b % 1024, swz = sb ^ (((sb >> 9) & 1) << 5); R = (st >> 1) * 16 + swz / 64; C = (st & 1) * 32 + (swz % 64) / 2; }
DI int perm32(int rho) { const int n = rho >> 4, i = rho & 15; return 8 * (i >> 2) + 4 * n + (i & 3); }
struct Unit { int pm, pn; };
struct Gemm { const bf16_t* A; const bf16_t* Bt; int M, N, K; int a_tm; int b_tm; };
struct StaticOrder {
    int nM, nN, nwg, G, c, rev, wgm;
    DI void init(int M, int N, int G_, int c_, int rev_ = 0, int wgm_ = WGM) { nM = M / BM; nN = N / BM; nwg = nM * nN; G = G_; c = c_; rev = rev_; wgm = wgm_; }
    DI bool next(int i, Unit& u) const {
        const long L = (long)i * G + c; if (L >= nwg) return false;
        int wgid = (int)L; { const int q = nwg / NXCD, r = nwg % NXCD, xcd = wgid % NXCD, off = wgid / NXCD; wgid = (xcd < r ? xcd * (q + 1) : r * (q + 1) + (xcd - r) * q) + off; }
        const int nig = wgm * nN, gid = wgid / nig, fm = gid * wgm, gsz = (nM - fm) < wgm ? (nM - fm) : wgm;
        u.pm = fm + ((wgid % nig) % gsz); u.pn = (wgid % nig) / gsz; if (rev) u.pm = nM - 1 - u.pm; return true;
    }
};

template <class Epi>
DI void gemm_phase(LAS unsigned char* lds, const Gemm g, const StaticOrder& S, const Epi& E, const int wave_id) {
    const int tid = opaque_tid(wave_id), wid = __builtin_amdgcn_readfirstlane(tid >> 6), lane = tid & 63, wr = wid >> 2, wc = wid & 3, fr = lane & 15, fq = lane >> 4;
    const int K = g.K, nt = K / BK;
    unsigned voffA[2], voffB[2];
#pragma unroll
    for (int i = 0; i < 2; ++i) { int R, C; stage_rc(tid * 16 + i * 8192, R, C); const int Rb = Epi::PERM ? ((R & ~31) + perm32(R & 31)) : R;
        voffA[i] = (unsigned)(R * (g.a_tm ? BK : K) + C) * 2u; voffB[i] = (unsigned)(Rb * (g.b_tm ? BK : K) + C) * 2u; }
    const size_t kstep = g.b_tm ? (size_t)(BM * BK * 2) : (size_t)(BK * 2);
    const size_t hstep = g.b_tm ? (size_t)(HALF * BK * 2) : (size_t)HALF * K * 2;
    const size_t tstep = g.b_tm ? (size_t)nt * (BM * BK * 2) : (size_t)BM * K * 2;
    const size_t kstepA = g.a_tm ? (size_t)(BM * BK * 2) : (size_t)(BK * 2);
    const size_t hstepA = g.a_tm ? (size_t)(HALF * BK * 2) : (size_t)HALF * K * 2;
    const size_t tstepA = g.a_tm ? (size_t)nt * (BM * BK * 2) : (size_t)BM * K * 2;
    const unsigned ldsw = (unsigned)wid * 1024u;
    const int aoff = lds_byte(wr * 64 + fr, fq * 8), boff = lds_byte(wc * 32 + fr, fq * 8);
#define PG8_SA(b, h) (((b) * 2 + (h)) * HTB)
#define PG8_SB(b, h) ((4 + (b) * 2 + (h)) * HTB)
#define PG8_STAGE(bufoff, gbase, voff) do { _Pragma("unroll") for (int _i = 0; _i < 2; ++_i) \
        __builtin_amdgcn_global_load_lds((const unsigned*)((const char*)(gbase) + (voff)[_i]), (LAS unsigned*)(lds + (bufoff) + ldsw + _i * 8192), 16, 0, 0); } while (0)
#define PG8_LDA(dst, b, h) do { _Pragma("unroll") for (int m = 0; m < 4; ++m) _Pragma("unroll") for (int k = 0; k < 2; ++k) dst[m][k] = *(const LAS bf16x8*)(lds + PG8_SA(b, h) + aoff + m * 2048 + k * 1024); } while (0)
#define PG8_LDB(dst, b, h) do { _Pragma("unroll") for (int n = 0; n < 2; ++n) _Pragma("unroll") for (int k = 0; k < 2; ++k) dst[n][k] = *(const LAS bf16x8*)(lds + PG8_SB(b, h) + boff + n * 2048 + k * 1024); } while (0)
#define PG8_MMA(ai, bj, At, Bt) do { __builtin_amdgcn_s_setprio(1); _Pragma("unroll") for (int m = 0; m < 4; ++m) _Pragma("unroll") for (int n = 0; n < 2; ++n) _Pragma("unroll") for (int k = 0; k < 2; ++k) \
        acc[ai][bj][m][n] = __builtin_amdgcn_mfma_f32_16x16x32_bf16(Bt[n][k], At[m][k], acc[ai][bj][m][n], 0, 0, 0); __builtin_amdgcn_s_setprio(0); } while (0)
#define PG8_WAIT_V(n) asm volatile("s_waitcnt vmcnt(" #n ")" ::: "memory")
#define PG8_WAIT_L(n) asm volatile("s_waitcnt lgkmcnt(" #n ")" ::: "memory")
#define PG8_BAR __builtin_amdgcn_s_barrier()
#define PG8_SCHED __builtin_amdgcn_sched_barrier(0)
    Unit cur, nxt; int ui = 0;
    if (!S.next(0, cur)) return;
    f32x4 acc[2][2][4][2];
#pragma unroll
    for (int a = 0; a < 2; ++a)
#pragma unroll
        for (int b = 0; b < 2; ++b)
#pragma unroll
            for (int m = 0; m < 4; ++m)
#pragma unroll
                for (int n = 0; n < 2; ++n) acc[a][b][m][n] = (f32x4){0.f, 0.f, 0.f, 0.f};
    bf16x8 At[4][2], B0[2][2], B1[2][2];
    const char* cA = (const char*)g.A + (size_t)cur.pm * tstepA; const char* cB = (const char*)g.Bt + (size_t)cur.pn * tstep;
    PG8_STAGE(PG8_SB(0, 0), cB, voffB); PG8_STAGE(PG8_SB(0, 1), cB + hstep, voffB); PG8_STAGE(PG8_SA(0, 0), cA, voffA); PG8_STAGE(PG8_SA(0, 1), cA + hstepA, voffA);
    if (wr == 1) PG8_BAR;
    PG8_WAIT_V(2); PG8_BAR;
    PG8_STAGE(PG8_SB(1, 0), cB + kstep, voffB); PG8_STAGE(PG8_SA(1, 0), cA + kstepA, voffA); PG8_STAGE(PG8_SB(1, 1), cB + hstep + kstep, voffB);
    PG8_WAIT_V(6); PG8_BAR;
    for (;;) {
        const bool has_next = S.next(ui + 1, nxt);
        const char* nA = has_next ? (const char*)g.A + (size_t)nxt.pm * tstepA : cA; const char* nB = has_next ? (const char*)g.Bt + (size_t)nxt.pn * tstep : cB;
        for (int t = 0; t < nt; t += 2) {
            const bool last = (t == nt - 2);
            const char* a1 = cA + (size_t)(t + 1) * kstepA;
            const char* a2 = last ? nA : cA + (size_t)(t + 2) * kstepA; const char* b2 = last ? nB : cB + (size_t)(t + 2) * kstep;
            const char* a3 = a2 + kstepA; const char* b3 = b2 + kstep;
            PG8_LDB(B0, 0, 0); PG8_LDB(B1, 0, 1); PG8_SCHED; PG8_LDA(At, 0, 0); PG8_STAGE(PG8_SA(1, 1), a1 + hstepA, voffA);
            PG8_WAIT_V(8); PG8_WAIT_L(0); PG8_BAR; PG8_MMA(0, 0, At, B0); PG8_MMA(0, 1, At, B1); PG8_BAR; PG8_SCHED;
            PG8_LDA(At, 0, 1); PG8_STAGE(PG8_SB(0, 0), b2, voffB); PG8_STAGE(PG8_SB(0, 1), b2 + hstep, voffB); PG8_STAGE(PG8_SA(0, 0), a2, voffA);
            PG8_WAIT_V(8); PG8_WAIT_L(0); PG8_BAR; PG8_MMA(1, 0, At, B0); PG8_MMA(1, 1, At, B1); PG8_BAR; PG8_SCHED;
            PG8_LDB(B0, 1, 0); PG8_LDB(B1, 1, 1); PG8_SCHED; PG8_LDA(At, 1, 0); PG8_STAGE(PG8_SA(0, 1), a2 + hstepA, voffA);
            PG8_WAIT_V(8); PG8_WAIT_L(0); PG8_BAR; PG8_MMA(0, 0, At, B0); PG8_MMA(0, 1, At, B1); PG8_BAR; PG8_SCHED;
            PG8_LDA(At, 1, 1); PG8_STAGE(PG8_SB(1, 0), b3, voffB); PG8_STAGE(PG8_SB(1, 1), b3 + hstep, voffB); PG8_STAGE(PG8_SA(1, 0), a3, voffA);
            PG8_WAIT_V(8); PG8_WAIT_L(0); PG8_BAR; PG8_MMA(1, 0, At, B0); PG8_MMA(1, 1, At, B1); PG8_BAR; PG8_SCHED;
        }
        if (wr == 0) PG8_BAR;
        PG8_SCHED; asm volatile("" ::: "memory");
        E(acc, cur, wr, wc, fr, fq);
        asm volatile("" ::: "memory"); PG8_SCHED;
        if (!has_next) break;
#pragma unroll
        for (int a = 0; a < 2; ++a)
#pragma unroll
            for (int b = 0; b < 2; ++b)
#pragma unroll
                for (int m = 0; m < 4; ++m)
#pragma unroll
                    for (int n = 0; n < 2; ++n) acc[a][b][m][n] = (f32x4){0.f, 0.f, 0.f, 0.f};
        cur = nxt; cA = nA; cB = nB; ++ui;
        if (wr == 1) PG8_BAR;
    }
    PG8_WAIT_V(0);
    PG8_BAR;
#undef PG8_SA
#undef PG8_SB
#undef PG8_STAGE
#undef PG8_LDA
#undef PG8_LDB
#undef PG8_MMA
#undef PG8_WAIT_V
#undef PG8_WAIT_L
#undef PG8_BAR
#undef PG8_SCHED
}
}
using pg8::Unit;

struct EpiSwiglu {
    static constexpr bool PERM = true;
    const float* ssq; const float* shw; bf16_t* act;
    DI void operator()(const f32x4 (&acc)[2][2][4][2], const Unit& u, int wr, int wc, int fr, int fq) const {
        const int mr = u.pm < 256 ? (u.pm >> 5) : 8;
        const int nb = u.pn * 256 + wc * 32 + 8 * fq;
        const int fb = u.pn * 128 + wc * 32 + 8 * fq;
        const int row0 = u.pm * 256 + wr * 64 + fr;
        const float* sp = shw + (size_t)mr * SHW_LD + nb;
        const f32x4 sg0 = *(const f32x4*)(sp), sg1 = *(const f32x4*)(sp + 4), su0 = *(const f32x4*)(sp + 128), su1 = *(const f32x4*)(sp + 132);
        float rs[2][4];
        rows_rstd(ssq, row0, fq, rs);
#pragma unroll
        for (int ai = 0; ai < 2; ++ai)
#pragma unroll
            for (int m = 0; m < 4; ++m) {
                const int row = row0 + ai * 128 + m * 16;
                const float r1 = rs[ai][m];
                const f32x4 g0 = acc[ai][0][m][0] * r1 + sg0, g1 = acc[ai][0][m][1] * r1 + sg1;
                const f32x4 u0 = acc[ai][1][m][0] * r1 + su0, u1 = acc[ai][1][m][1] * r1 + su1;
                f32x4 a0, a1;
#pragma unroll
                for (int j = 0; j < 4; ++j) { a0[j] = silu_f(g0[j]) * u0[j]; a1[j] = silu_f(g1[j]) * u1[j]; }
                *(u32x4*)(act + (((size_t)(u.pm * 44 + 2 * u.pn + (wc >> 1)) * 256 + (ai * 128 + wr * 64 + m * 16 + fr)) * 64 + (wc & 1) * 32 + 8 * fq)) = pack8(a0, a1);
            }
    }
};
template <bool WA> struct EpiRes {
    static constexpr bool PERM = true;
    const float* hin_lat; const float* hin_ctx; float* hout_lat; float* hout_ctx;
    const float* cvec; const float* gvec; const float* svec; bf16_t* Aout; float* ssq; float cmul; float pad_;
    DI void operator()(const f32x4 (&acc)[2][2][4][2], const Unit& u, int wr, int wc, int fr_in, int fq_in) const {
        int fr = fr_in, fq = fq_in; float cmul_o = cmul;
        asm volatile("" : "+v"(fr), "+v"(fq), "+v"(cmul_o));
        const int mr = u.pm < 256 ? (u.pm >> 5) : 8;
        const int cb = u.pn * 256 + wc * 32 + 8 * fq;
        const int row0 = u.pm * 256 + wr * 64 + fr;
        const bool lat = u.pm < 256;
        const float* hi0 = lat ? hin_lat : hin_ctx;
        float* ho0 = lat ? hout_lat : hout_ctx;
        const unsigned rb = (unsigned)(lat ? row0 : row0 - ML) * (unsigned)D;
        float ss[2][4];
#pragma unroll
        for (int ai = 0; ai < 2; ++ai)
#pragma unroll
            for (int m = 0; m < 4; ++m) ss[ai][m] = 0.f;
        f32x4 cf[2][2], gs[2][2];
#define ER_COEF(bj) do { const int c = cb + (bj) * 128; \
            cf[bj][0] = *(const f32x4*)(cvec + (size_t)mr * NMOD + c) * cmul_o; cf[bj][1] = *(const f32x4*)(cvec + (size_t)mr * NMOD + c + 4) * cmul_o; \
            if (WA) { gs[bj][0] = *(const f32x4*)(gvec + c) * (*(const f32x4*)(svec + (size_t)mr * NMOD + c) + 1.f); gs[bj][1] = *(const f32x4*)(gvec + c + 4) * (*(const f32x4*)(svec + (size_t)mr * NMOD + c + 4) + 1.f); } } while (0)
        ER_COEF(0);
#define ER_LOAD(hv, bj, ai) do { _Pragma("unroll") for (int m = 0; m < 4; ++m) { const unsigned ro = rb + (unsigned)(((ai) * 128 + m * 16) * D + cb + (bj) * 128); \
            hv[m][0] = *(const f32x4*)(hi0 + ro); hv[m][1] = *(const f32x4*)(hi0 + ro + 4); } } while (0)
#define ER_PROC(hv, bj, ai) do { _Pragma("unroll") for (int m = 0; m < 4; ++m) { const int c = cb + (bj) * 128; const unsigned ro = rb + (unsigned)(((ai) * 128 + m * 16) * D + c); \
            const f32x4 n0 = hv[m][0] + cf[bj][0] * acc[ai][bj][m][0], n1 = hv[m][1] + cf[bj][1] * acc[ai][bj][m][1]; \
            *(f32x4*)(ho0 + ro) = n0; *(f32x4*)(ho0 + ro + 4) = n1; \
            ss[ai][m] += ((n0[0] * n0[0] + n0[1] * n0[1]) + (n0[2] * n0[2] + n0[3] * n0[3])) + ((n1[0] * n1[0] + n1[1] * n1[1]) + (n1[2] * n1[2] + n1[3] * n1[3])); \
            if (WA) *(u32x4*)(Aout + (unsigned)((row0 + (ai) * 128 + m * 16) * D + c)) = pack8(n0 * gs[bj][0], n1 * gs[bj][1]); } } while (0)
#define ER_FENCE asm volatile("" ::: "memory")
        f32x4 h0[4][2], h1[4][2], h2[4][2], h3[4][2];
        ER_LOAD(h0, 0, 0); ER_FENCE;
        ER_PROC(h0, 0, 0); ER_FENCE;
        ER_LOAD(h1, 0, 1); ER_LOAD(h2, 1, 0); ER_FENCE;
        ER_PROC(h1, 0, 1); ER_FENCE;
        ER_LOAD(h3, 1, 1); ER_COEF(1); ER_FENCE;
        ER_PROC(h2, 1, 0); ER_FENCE;
        ER_PROC(h3, 1, 1); ER_FENCE;
#undef ER_LOAD
#undef ER_COEF
#undef ER_PROC
#undef ER_FENCE
#pragma unroll
        for (int ai = 0; ai < 2; ++ai)
#pragma unroll
            for (int m = 0; m < 4; ++m) {
                float v = ss[ai][m];
                v += __shfl_xor(v, 16); v += __shfl_xor(v, 32);
                if (fq == 0) ssq[(unsigned)((row0 + ai * 128 + m * 16) * 16 + u.pn * 4 + wc)] = v;
            }
    }
};
struct EpiConvIn {
    static constexpr bool PERM = true;
    const float* ssq; const float* shw; bf16_t* bg; bf16_t* z;
    DI void operator()(const f32x4 (&acc)[2][2][4][2], const Unit& u, int wr, int wc, int fr, int fq) const {
        const int mr = u.pm < 256 ? (u.pm >> 5) : 8;
        const int nb = u.pn * 256 + wc * 32 + 8 * fq;
        const float* sp = shw + (size_t)mr * SHW_LD + nb;
        const f32x4 s00 = *(const f32x4*)(sp), s01 = *(const f32x4*)(sp + 4), s10 = *(const f32x4*)(sp + 128), s11 = *(const f32x4*)(sp + 132);
        const bool isbg = u.pn < 4;
        const int ch = (u.pn - 4) * 128 + wc * 32 + 8 * fq;
        float rsv[2][4];
        rows_rstd(ssq, u.pm * 256 + wr * 64 + fr, fq, rsv);
#pragma unroll
        for (int ai = 0; ai < 2; ++ai)
#pragma unroll
            for (int m = 0; m < 4; ++m) {
                const int row = u.pm * 256 + ai * 128 + wr * 64 + m * 16 + fr;
                const float rs = rsv[ai][m];
                const f32x4 v00 = acc[ai][0][m][0] * rs + s00, v01 = acc[ai][0][m][1] * rs + s01;
                const f32x4 v10 = acc[ai][1][m][0] * rs + s10, v11 = acc[ai][1][m][1] * rs + s11;
                if (isbg) {
                    *(u32x4*)(bg + (size_t)row * D + nb) = pack8(v00, v01);
                    *(u32x4*)(bg + (size_t)row * D + nb + 128) = pack8(v10, v11);
                } else {
                    *(u32x4*)(z + (size_t)row * D + ch) = pack8(v00 * v10, v01 * v11);
                }
            }
    }
};
struct EpiHgIn {
    static constexpr bool PERM = true;
    const float* ssq; const float* shw; const float* lb; bf16_t* q; bf16_t* v; bf16_t* lffw; bf16_t* lfbw; bf16_t* sog;
    DI void operator()(const f32x4 (&acc)[2][2][4][2], const Unit& u, int wr, int wc, int fr, int fq) const {
        const int mr = u.pm < 256 ? (u.pm >> 5) : 8;
        const int seg = u.pn >> 2;
        const int nb = u.pn * 256 + wc * 32 + 8 * fq;
        const int cc = nb - seg * 1024;
        const int row0 = u.pm * 256 + wr * 64 + fr;
        const float* sp = shw + (size_t)mr * SHW_LD + nb;
        if ((seg == 0 || seg == 4) && u.pm >= 256) return;
        float rs[2][4];
        rows_rstd(ssq, row0, fq, rs);
        if (seg == 2 || seg == 3) {
            bf16_t* dst = (seg == 2 ? lffw : lfbw) + (size_t)row0 * D + cc;
            const float* lbp = lb + (seg - 2) * 1024 + cc;
#pragma unroll
            for (int bj = 0; bj < 2; ++bj) {
                const f32x4 sh0 = *(const f32x4*)(sp + bj * 128), sh1 = *(const f32x4*)(sp + bj * 128 + 4);
                const f32x4 lb0 = *(const f32x4*)(lbp + bj * 128), lb1 = *(const f32x4*)(lbp + bj * 128 + 4);
#pragma unroll
                for (int ai = 0; ai < 2; ++ai)
#pragma unroll
                    for (int m = 0; m < 4; ++m) {
                        f32x4 a0 = acc[ai][bj][m][0] * rs[ai][m] + sh0, a1 = acc[ai][bj][m][1] * rs[ai][m] + sh1;
#pragma unroll
                        for (int j = 0; j < 4; ++j) {
                            a0[j] = lb0[j] + (1.f - lb0[j]) * sigmoid_f(a0[j]);
                            a1[j] = lb1[j] + (1.f - lb1[j]) * sigmoid_f(a1[j]);
                        }
                        u32x4 w; w.x = pk_f16(a0[0], a0[1]); w.y = pk_f16(a0[2], a0[3]); w.z = pk_f16(a1[0], a1[1]); w.w = pk_f16(a1[2], a1[3]);
                        *(u32x4*)(dst + (size_t)(ai * 128 + m * 16) * D + bj * 128) = w;
                    }
            }
        } else {
            bf16_t* pq = q; bf16_t* pv = v; bf16_t* ps = sog;
            asm volatile("" : "+s"(pq), "+s"(pv), "+s"(ps));
            bf16_t* dst = (seg == 0 ? pq : seg == 1 ? pv : ps) + (size_t)row0 * D + cc;
            const bool act = seg != 1;
#pragma unroll
            for (int bj = 0; bj < 2; ++bj) {
                const f32x4 sh0 = *(const f32x4*)(sp + bj * 128), sh1 = *(const f32x4*)(sp + bj * 128 + 4);
#pragma unroll
                for (int ai = 0; ai < 2; ++ai)
#pragma unroll
                    for (int m = 0; m < 4; ++m) {
                        f32x4 a0 = acc[ai][bj][m][0] * rs[ai][m] + sh0, a1 = acc[ai][bj][m][1] * rs[ai][m] + sh1;
                        if (act) {
#pragma unroll
                            for (int j = 0; j < 4; ++j) { a0[j] = silu_f(a0[j]); a1[j] = silu_f(a1[j]); }
                        }
                        *(u32x4*)(dst + (size_t)(ai * 128 + m * 16) * D + bj * 128) = pack8(a0, a1);
                    }
            }
        }
    }
};

DI void prep0(LAS unsigned char* lds, const Params& p, const int wave_id) {
    const int tid = opaque_tid(wave_id), G = gridDim.x, bid = blockIdx.x;
    float* mods = (float*)(p.ws + OFF_MODS);
    if (bid == 0) for (int i = tid; i < 2048; i += NTHREADS) { const float l0 = p.lb_logits[i], l1 = p.lb_logits[2048 + i]; ((float*)(p.ws + OFF_LB))[i] = 1.f / (1.f + __expf(l0 - l1)); }
    {
        LAS float* sS = (LAS float*)lds;
        LAS float* red = (LAS float*)(lds + 36864);
        if (bid < 288) {
            for (int i = tid; i < 9 * 1024; i += NTHREADS) { const int mr = i >> 10, k = i & 1023; const float v = mr < 8 ? p.c[mr * 1024 + k] : p.c_ctx[k]; sS[i] = v / (1.f + __expf(-v)); }
            __syncthreads();
            for (int t = bid; t < 288; t += G) {
                const int l = t / 144, cb = t % 144, kg = tid >> 6, cl = tid & 63, col = cb * 64 + cl;
                const float* W = p.ada_w + (size_t)l * 1024 * NMOD + col;
                float a[9];
#pragma unroll
                for (int mr = 0; mr < 9; ++mr) a[mr] = 0.f;
                for (int k = kg * 128; k < kg * 128 + 128; ++k) {
                    const float w = W[(size_t)k * NMOD];
#pragma unroll
                    for (int mr = 0; mr < 9; ++mr) a[mr] += sS[mr * 1024 + k] * w;
                }
#pragma unroll
                for (int mr = 0; mr < 9; ++mr) red[(kg * 9 + mr) * 64 + cl] = a[mr];
                __syncthreads();
                for (int i = tid; i < 576; i += NTHREADS) {
                    const int mr = i >> 6, c2 = i & 63; float s = 0.f;
#pragma unroll
                    for (int k2 = 0; k2 < 8; ++k2) s += red[(k2 * 9 + mr) * 64 + c2];
                    const int cc = cb * 64 + c2;
                    mods[(size_t)(l * 9 + mr) * NMOD + cc] = s + p.ada_b[l * NMOD + cc];
                }
                __syncthreads();
            }
        }
    }
    __syncthreads();
    LAS float* tile = (LAS float*)lds;
    struct TileDesc { const float* src; bf16_t* dst; int K; };
    auto tile_desc = [&](int t, const float*& srcp, bf16_t*& dstp, int& Kout) {
        const float* src; bf16_t* dst; int K, Ns, nT, kind; int tt = t;
        if (tt < 5632) { const int i = tt / 1408; tt %= 1408; src = p.w_gu + (size_t)i * 1024 * 5632; dst = (bf16_t*)(p.ws + OFF_WGU + i * SZ_WGU1); K = 1024; Ns = 5632; nT = 88; kind = 1; }
        else if (tt < 8448) { tt -= 5632; const int i = tt / 704; tt %= 704; src = p.w_dn + (size_t)i * 2816 * 1024; dst = (bf16_t*)(p.ws + OFF_WDN + i * SZ_WDN1); K = 2816; Ns = 1024; nT = 16; kind = 0; }
        else if (tt < 9216) { tt -= 8448; src = p.cw_in; dst = (bf16_t*)(p.ws + OFF_WCIN); K = 1024; Ns = 3072; nT = 48; kind = 2; }
        else if (tt < 9472) { tt -= 9216; src = p.cw_out; dst = (bf16_t*)(p.ws + OFF_WCOUT); K = 1024; Ns = 1024; nT = 16; kind = 0; }
        else if (tt < 10752) { tt -= 9472; src = p.hw_in; dst = (bf16_t*)(p.ws + OFF_WHIN); K = 1024; Ns = 5120; nT = 80; kind = 0; }
        else { tt -= 10752; src = p.hw_out; dst = (bf16_t*)(p.ws + OFF_WHOUT); K = 1024; Ns = 1024; nT = 16; kind = 0; }
        const int tk = tt / nT, tn = tt % nT, k0 = tk * 64, n0 = tn * 64;
        int sc0 = n0;
        if (kind == 1) { const int t2 = n0 >> 8, w = n0 & 255; sc0 = (w >> 7) * 2816 + t2 * 128 + (w & 127); }
        else if (kind == 2 && n0 >= 1024) { const int q = n0 - 1024, t2 = q >> 8, w = q & 255; sc0 = 1024 + (w >> 7) * 1024 + t2 * 128 + (w & 127); }
        srcp = src + (size_t)(k0 + (tid >> 4)) * Ns + sc0 + (tid & 15) * 4;
        { const int n = n0 + (tid >> 3);
          dstp = (t >= 5632 && t < 8448) ? dst + ((size_t)((n >> 8) * 44 + (k0 >> 6)) * 256 + (n & 255)) * 64 + (tid & 7) * 8
                                         : dst + (size_t)n * K + k0 + (tid & 7) * 8; }
        Kout = Ns;
    };
    {
        LAS float* tile2 = (LAS float*)(lds + 64 * 65 * 4);
        int t = bid;
        const float* srcp[2] = {nullptr, nullptr}; bf16_t* dstp[2] = {nullptr, nullptr}; int Ns[2] = {0, 0};
        f32x4 v[2][2];
#pragma unroll
        for (int k = 0; k < 2; ++k) { v[k][0] = (f32x4){0.f, 0.f, 0.f, 0.f}; v[k][1] = v[k][0];
            if (t + k * G < 11008) { tile_desc(t + k * G, srcp[k], dstp[k], Ns[k]); v[k][0] = *(const f32x4*)(srcp[k]); v[k][1] = *(const f32x4*)(srcp[k] + (size_t)32 * Ns[k]); } }
        while (t < 11008) {
            const int kk = tid >> 4, c4 = (tid & 15) * 4;
            bf16_t* dcur[2]; bool have[2];
#pragma unroll
            for (int k = 0; k < 2; ++k) {
                LAS float* tl = k ? tile2 : tile;
                tl[kk * 65 + c4 + 0] = v[k][0][0]; tl[kk * 65 + c4 + 1] = v[k][0][1]; tl[kk * 65 + c4 + 2] = v[k][0][2]; tl[kk * 65 + c4 + 3] = v[k][0][3];
                tl[(kk + 32) * 65 + c4 + 0] = v[k][1][0]; tl[(kk + 32) * 65 + c4 + 1] = v[k][1][1]; tl[(kk + 32) * 65 + c4 + 2] = v[k][1][2]; tl[(kk + 32) * 65 + c4 + 3] = v[k][1][3];
                dcur[k] = dstp[k]; have[k] = (t + k * G) < 11008;
            }
            const int tn = t + 2 * G;
#pragma unroll
            for (int k = 0; k < 2; ++k)
                if (tn + k * G < 11008) { tile_desc(tn + k * G, srcp[k], dstp[k], Ns[k]); v[k][0] = *(const f32x4*)(srcp[k]); v[k][1] = *(const f32x4*)(srcp[k] + (size_t)32 * Ns[k]); }
            LDS_BARRIER();
#pragma unroll
            for (int k = 0; k < 2; ++k) {
                if (have[k]) {
                    const LAS float* tl = k ? tile2 : tile;
                    const int n = tid >> 3, k8 = (tid & 7) * 8;
                    float v8[8];
#pragma unroll
                    for (int i = 0; i < 8; ++i) v8[i] = tl[(k8 + i) * 65 + n];
                    u32x4 o; o.x = cvt_pk_bf16(v8[0], v8[1]); o.y = cvt_pk_bf16(v8[2], v8[3]); o.z = cvt_pk_bf16(v8[4], v8[5]); o.w = cvt_pk_bf16(v8[6], v8[7]);
                    *(u32x4*)(dcur[k]) = o;
                }
            }
            LDS_BARRIER();
            t = tn;
        }
    }
}

DI void prep1(LAS unsigned char* lds, const Params& p, const int wave_id) {
    const int tid = opaque_tid(wave_id), G = gridDim.x, bid = blockIdx.x, wave = tid >> 6, lane = tid & 63;
    const float* mods = (const float*)(p.ws + OFF_MODS);
    float* shw = (float*)(p.ws + OFF_SHW);
    LAS float* sh = (LAS float*)lds;
    for (int sl = 0; sl < 6; ++sl) {
        const int l = sl / 3, j = sl % 3;
        const float* mv = mods + (size_t)l * 9 * NMOD + (3 * j) * 1024;
        for (int i = tid; i < 9216; i += NTHREADS) { const int mr = i >> 10, k = i & 1023; sh[i] = mv[(size_t)mr * NMOD + k]; }
        __syncthreads();
        const bf16_t* Wt; int N;
        if (sl == 0) { Wt = (const bf16_t*)(p.ws + OFF_WGU); N = 5632; }
        else if (sl == 1) { Wt = (const bf16_t*)(p.ws + OFF_WCIN); N = 3072; }
        else if (sl == 2) { Wt = (const bf16_t*)(p.ws + OFF_WGU + SZ_WGU1); N = 5632; }
        else if (sl == 3) { Wt = (const bf16_t*)(p.ws + OFF_WGU + 2 * SZ_WGU1); N = 5632; }
        else if (sl == 4) { Wt = (const bf16_t*)(p.ws + OFF_WHIN); N = 5120; }
        else { Wt = (const bf16_t*)(p.ws + OFF_WGU + 3 * SZ_WGU1); N = 5632; }
        for (int n = bid * 8 + wave; n < N; n += G * 8) {
            const u32x4* wp = (const u32x4*)(Wt + (size_t)n * 1024 + lane * 16);
            const u32x4 w0 = wp[0], w1 = wp[1];
            float wf[16];
#pragma unroll
            for (int i = 0; i < 4; ++i) { wf[2 * i] = bf_lo(w0[i]); wf[2 * i + 1] = bf_hi(w0[i]); wf[8 + 2 * i] = bf_lo(w1[i]); wf[8 + 2 * i + 1] = bf_hi(w1[i]); }
            float res = 0.f;
#pragma unroll
            for (int mr = 0; mr < 9; ++mr) {
                const LAS f32x4* sp = (const LAS f32x4*)(sh + mr * 1024 + lane * 16);
                float a = 0.f;
#pragma unroll
                for (int q4 = 0; q4 < 4; ++q4) { const f32x4 s = sp[q4]; a += s[0] * wf[4 * q4] + s[1] * wf[4 * q4 + 1] + s[2] * wf[4 * q4 + 2] + s[3] * wf[4 * q4 + 3]; }
#pragma unroll
                for (int off = 32; off >= 1; off >>= 1) a += __shfl_xor(a, off);
                if (lane == mr) res = a;
            }
            if (lane < 9) shw[(size_t)(sl * 9 + lane) * SHW_LD + n] = res;
        }
        __syncthreads();
    }
    bf16_t* A0 = (bf16_t*)(p.ws + OFF_S0);
    float* ssq = (float*)(p.ws + OFF_SSQ);
    const int NR = MT / 2;
    for (int r0 = bid * 8 + wave; r0 < NR; r0 += G * 8) {
        f32x4 xv[2][4];
#pragma unroll
        for (int k = 0; k < 2; ++k) {
            const int r = r0 + k * NR;
            const float* xr = r < ML ? p.x + (size_t)r * D : p.ctx + (size_t)(r - ML) * D;
#pragma unroll
            for (int q4 = 0; q4 < 4; ++q4) xv[k][q4] = *(const f32x4*)(xr + lane * 16 + 4 * q4);
        }
#pragma unroll
        for (int k = 0; k < 2; ++k) {
            const int r = r0 + k * NR;
            const int mr = r < ML ? (r >> 13) : 8;
            const float* gp = p.norm_g + lane * 16;
            const float* sc = mods + (size_t)mr * NMOD + 1024 + lane * 16;
            float ss = 0.f; f32x4 a[4];
#pragma unroll
            for (int q4 = 0; q4 < 4; ++q4) {
                const f32x4 x4 = xv[k][q4], gv = *(const f32x4*)(gp + 4 * q4), sv = *(const f32x4*)(sc + 4 * q4);
                ss += (x4[0] * x4[0] + x4[1] * x4[1]) + (x4[2] * x4[2] + x4[3] * x4[3]);
                a[q4] = x4 * gv * (sv + 1.f);
            }
#pragma unroll
            for (int off = 32; off >= 1; off >>= 1) ss += __shfl_xor(ss, off);
            u32x4* op = (u32x4*)(A0 + (size_t)r * D + lane * 16);
            op[0] = pack8(a[0], a[1]); op[1] = pack8(a[2], a[3]);
            if (lane < 16) ssq[(size_t)r * 16 + lane] = lane == 0 ? ss : 0.f;
        }
    }
}

DI void unpack8(const u32x4 w, float* f) {
#pragma unroll
    for (int i = 0; i < 4; ++i) { f[2 * i] = bf_lo(w[i]); f[2 * i + 1] = bf_hi(w[i]); }
}

DI void conv_phase(const Params& p, const int wave_id) {
    const int tid = opaque_tid(wave_id), G = gridDim.x, bid = blockIdx.x, wave = tid >> 6, lane = tid & 63;
    const bf16_t* bg = (const bf16_t*)(p.ws + OFF_S1); const bf16_t* z = (const bf16_t*)(p.ws + OFF_S2); bf16_t* U = (bf16_t*)(p.ws + OFF_S3);
    const int ch0 = lane * 16;
    float w0[16], w1[16], w2[16];
#pragma unroll
    for (int i = 0; i < 16; ++i) { w0[i] = p.cw[ch0 + i]; w1[i] = p.cw[1024 + ch0 + i]; w2[i] = p.cw[2048 + ch0 + i]; }
    const int NR = MT / 2;
    for (int rr = bid * 8 + wave; rr < NR; rr += G * 8) {
        const int r0 = NR - 1 - rr;
        u32x4 zp[2][2], zc[2][2], zn[2][2], bv[2][2];
#pragma unroll
        for (int k = 0; k < 2; ++k) {
            const int r = r0 + k * NR;
            bool hp, hn; int st;
            if (r < ML) {
                const int t = r & 8191, col = t & 63, ri = t >> 6;
                if (lane < 32) { hp = col > 0; hn = col < 63; st = 1; } else { hp = ri > 0; hn = ri < 127; st = 64; }
            } else { const int tc = (r - ML) & 255; hp = tc > 0; hn = tc < 255; st = 1; }
#pragma unroll
            for (int hf = 0; hf < 2; ++hf) {
                const size_t o = (size_t)r * D + ch0 + hf * 8;
                const u32x4 zero = {0u, 0u, 0u, 0u};
                zp[k][hf] = hp ? *(const u32x4*)(z + o - (size_t)st * D) : zero;
                zc[k][hf] = *(const u32x4*)(z + o);
                zn[k][hf] = hn ? *(const u32x4*)(z + o + (size_t)st * D) : zero;
                bv[k][hf] = *(const u32x4*)(bg + o);
            }
        }
#pragma unroll
        for (int k = 0; k < 2; ++k) {
            const int r = r0 + k * NR;
#pragma unroll
            for (int hf = 0; hf < 2; ++hf) {
                const size_t o = (size_t)r * D + ch0 + hf * 8;
                float fp[8], fc[8], fn[8], fb[8], r8[8];
                unpack8(zp[k][hf], fp); unpack8(zc[k][hf], fc); unpack8(zn[k][hf], fn); unpack8(bv[k][hf], fb);
#pragma unroll
                for (int i = 0; i < 8; ++i) r8[i] = fb[i] * (w0[hf * 8 + i] * fp[i] + w1[hf * 8 + i] * fc[i] + w2[hf * 8 + i] * fn[i]);
                u32x4 ov; ov.x = cvt_pk_bf16(r8[0], r8[1]); ov.y = cvt_pk_bf16(r8[2], r8[3]); ov.z = cvt_pk_bf16(r8[4], r8[5]); ov.w = cvt_pk_bf16(r8[6], r8[7]);
                *(u32x4*)(U + o) = ov;
            }
        }
    }
}

DI void gate_phase(const Params& p, const int wave_id) {
    const int tid = opaque_tid(wave_id), G = gridDim.x, bid = blockIdx.x, wave = tid >> 6, lane = tid & 63;
    bf16_t* X = (bf16_t*)(p.ws + OFF_S0); const bf16_t* Y = (const bf16_t*)(p.ws + OFF_S6); const bf16_t* sog = (const bf16_t*)(p.ws + OFF_S5);
    const int c0 = lane * 16;
    float gn[16];
#pragma unroll
    for (int i = 0; i < 16; ++i) gn[i] = p.gnorm[c0 + i];
    const int NR = ML / 2;
    for (int r0 = bid * 8 + wave; r0 < NR; r0 += G * 8) {
        u32x4 xv[2][2], yv[2][2], sgv[2][2];
#pragma unroll
        for (int k = 0; k < 2; ++k) {
            const size_t o = (size_t)(r0 + k * NR) * D + c0;
            xv[k][0] = *(const u32x4*)(X + o); xv[k][1] = *(const u32x4*)(X + o + 8);
            yv[k][0] = *(const u32x4*)(Y + o); yv[k][1] = *(const u32x4*)(Y + o + 8);
            sgv[k][0] = *(const u32x4*)(sog + o); sgv[k][1] = *(const u32x4*)(sog + o + 8);
        }
#pragma unroll
        for (int k = 0; k < 2; ++k) {
            const size_t o = (size_t)(r0 + k * NR) * D + c0;
            float ov[16], sv[16], a[8], b[8];
            unpack8(xv[k][0], a); unpack8(yv[k][0], b);
#pragma unroll
            for (int i = 0; i < 8; ++i) ov[i] = a[i] + b[i];
            unpack8(xv[k][1], a); unpack8(yv[k][1], b);
#pragma unroll
            for (int i = 0; i < 8; ++i) ov[8 + i] = a[i] + b[i];
            unpack8(sgv[k][0], sv); unpack8(sgv[k][1], sv + 8);
            float ss = 0.f;
#pragma unroll
            for (int i = 0; i < 16; ++i) ss += ov[i] * ov[i];
            ss += __shfl_xor(ss, 1); ss += __shfl_xor(ss, 2); ss += __shfl_xor(ss, 4);
            const float rs = rsqrtf(ss * (1.f / 128.f) + EPS);
            float r16[16];
#pragma unroll
            for (int i = 0; i < 16; ++i) r16[i] = ov[i] * rs * gn[i] * sv[i];
            u32x4 o0, o1;
            o0.x = cvt_pk_bf16(r16[0], r16[1]); o0.y = cvt_pk_bf16(r16[2], r16[3]); o0.z = cvt_pk_bf16(r16[4], r16[5]); o0.w = cvt_pk_bf16(r16[6], r16[7]);
            o1.x = cvt_pk_bf16(r16[8], r16[9]); o1.y = cvt_pk_bf16(r16[10], r16[11]); o1.z = cvt_pk_bf16(r16[12], r16[13]); o1.w = cvt_pk_bf16(r16[14], r16[15]);
            *(u32x4*)(X + o) = o0; *(u32x4*)(X + o + 8) = o1;
        }
    }
}

DI void final_phase(const Params& p, const int wave_id) {
    const int tid = opaque_tid(wave_id), G = gridDim.x, bid = blockIdx.x, wave = tid >> 6, lane = tid & 63;
    const float* ssq = (const float*)(p.ws + OFF_SSQ);
    f32x4 g[4];
#pragma unroll
    for (int q4 = 0; q4 < 4; ++q4) g[q4] = *(const f32x4*)(p.final_g + q4 * 256 + lane * 4);
    const int NR = ML / 2;
    for (int r0 = bid * 8 + wave; r0 < NR; r0 += G * 8) {
        f32x4 v[2][4]; float rs[2];
#pragma unroll
        for (int k = 0; k < 2; ++k) {
            const int r = r0 + k * NR;
            const float* hp = (const float*)(p.ws + OFF_S4) + (size_t)r * D + lane * 4;
#pragma unroll
            for (int q4 = 0; q4 < 4; ++q4) v[k][q4] = *(const f32x4*)(hp + q4 * 256);
            rs[k] = row_rstd(ssq, r);
        }
#pragma unroll
        for (int k = 0; k < 2; ++k) {
            const int r = r0 + k * NR;
            float* op = p.out + (size_t)r * D + lane * 4;
#pragma unroll
            for (int q4 = 0; q4 < 4; ++q4) { f32x4 o = v[k][q4] * rs[k] * g[q4];
#ifdef PROBE_LO
                if (r < 256) o = o + *(const float*)(p.ws + OFF_DBG);
#endif
                *(f32x4*)(op + q4 * 256) = o; }
        }
    }
}

DI void scan_phase(LAS unsigned char* lds, const Params& p, const int wave_id) {
    constexpr int QSTR = 272, SSTR = 144;
    constexpr int O_QT = 0, O_KT = 2 * 64 * QSTR, O_KDT = O_KT + 64 * QSTR, O_VT = O_KDT + 128 * SSTR, O_ATT = O_VT + 2 * 64 * SSTR, O_ST = O_ATT + 64 * SSTR,
                  O_SEG = O_ST + 2 * 64 * QSTR, O_DEC = O_SEG + 4096;
    static_assert(O_DEC + 512 <= 139264, "scan LDS");
    typedef float f32x2 __attribute__((ext_vector_type(2)));
    typedef _Float16 h2 __attribute__((ext_vector_type(2)));
    const int tid = opaque_tid(wave_id), wv = __builtin_amdgcn_readfirstlane(tid >> 6), lane = tid & 63, fr = lane & 15, fq = lane >> 4;
    const bf16_t* Qb = (const bf16_t*)(p.ws + OFF_S4); const bf16_t* Vb = (const bf16_t*)(p.ws + OFF_S1);
    for (int w = blockIdx.x; w < 256; w += gridDim.x) {
        const int xx = w & 7, yy = w >> 3, pair = xx * 8 + (yy >> 2), sub = yy & 3, dir = sub & 1, eh = sub >> 1, b = pair >> 3, h = pair & 7;
        const _Float16* FG = (const _Float16*)(p.ws + (dir ? OFF_S3 : OFF_S2));
        bf16_t* Ob = (bf16_t*)(p.ws + (dir ? OFF_S6 : OFF_S0));
        const int colq = h * 128 + 2 * lane, colv = h * 128 + eh * 64 + lane;
        f32x4 Sacc[4];
#pragma unroll
        for (int i = 0; i < 4; ++i) Sacc[i] = (f32x4){0.f, 0.f, 0.f, 0.f};
        for (int i = tid; i < 64 * QSTR / 4; i += NTHREADS) ((LAS unsigned*)(lds + O_ST))[i] = 0u;
        auto chunk_base = [&](int c) -> int {
            if (c < 4) return ML + b * 256 + (dir ? (3 - c) : c) * 64;
            return b * 8192 + (dir ? (127 - (c - 4)) : (c - 4)) * 64;
        };
        auto o_step = [&](int cc) {
            const int pb = cc & 1, obase = chunk_base(cc), ti = wv >> 1;
#pragma unroll
            for (int rep = 0; rep < 2; ++rep) {
                const int ei = (wv & 1) * 2 + rep;
                f32x4 oacc = {0.f, 0.f, 0.f, 0.f};
#pragma unroll
                for (int kk = 0; kk < 2; ++kk) {
                    const bf16x8 a = *(const LAS bf16x8*)(lds + O_VT + pb * 64 * SSTR + (16 * ei + fr) * SSTR + (32 * kk + 8 * fq) * 2);
                    const bf16x8 bb = *(const LAS bf16x8*)(lds + O_ATT + (16 * ti + fr) * SSTR + (32 * kk + 8 * fq) * 2);
                    oacc = __builtin_amdgcn_mfma_f32_16x16x32_bf16(a, bb, oacc, 0, 0, 0);
                }
#pragma unroll
                for (int kk = 0; kk < 4; ++kk) {
                    const bf16x8 a = *(const LAS bf16x8*)(lds + O_ST + pb * 64 * QSTR + (16 * ei + fr) * QSTR + (32 * kk + 8 * fq) * 2);
                    const bf16x8 bb = *(const LAS bf16x8*)(lds + O_QT + pb * 64 * QSTR + (16 * ti + fr) * QSTR + (32 * kk + 8 * fq) * 2);
                    oacc = __builtin_amdgcn_mfma_f32_16x16x32_bf16(a, bb, oacc, 0, 0, 0);
                }
                const int t = 16 * ti + fr; const int row = obase + (dir ? 63 - t : t);
                u32x2 ow; ow.x = cvt_pk_bf16(oacc[0], oacc[1]); ow.y = cvt_pk_bf16(oacc[2], oacc[3]);
                *(u32x2*)(Ob + (size_t)row * D + h * 128 + eh * 64 + 16 * ei + 4 * fq) = ow;
            }
        };
        unsigned fpk[8], qpk[8]; bf16_t vr[8];
        {
            const int base = chunk_base(0);
#pragma unroll
            for (int i = 0; i < 8; ++i) { const int j = wv * 8 + i; const int row = base + (dir ? 63 - j : j);
                fpk[i] = *(const unsigned*)(FG + (size_t)row * D + colq); qpk[i] = 0u; vr[i] = Vb[(size_t)row * D + colv]; }
        }
        LDS_BARRIER();
        for (int c = 0; c < 132; ++c) {
            const bool lat = c >= 4;
            const int buf = c & 1;
            float f0[8], f1[8], q0[8], q1[8], vf[8];
#pragma unroll
            for (int i = 0; i < 8; ++i) { const h2 hv = __builtin_bit_cast(h2, fpk[i]); f0[i] = (float)hv[0]; f1[i] = (float)hv[1]; q0[i] = bf_lo(qpk[i]); q1[i] = bf_hi(qpk[i]); vf[i] = __uint_as_float((unsigned)vr[i] << 16); }
            if (c + 1 < 132) {
                const int nb = chunk_base(c + 1); const bool nlat = (c + 1) >= 4;
#pragma unroll
                for (int i = 0; i < 8; ++i) { const int j = wv * 8 + i; const int row = nb + (dir ? 63 - j : j);
                    fpk[i] = *(const unsigned*)(FG + (size_t)row * D + colq); qpk[i] = nlat ? *(const unsigned*)(Qb + (size_t)row * D + colq) : 0u; vr[i] = Vb[(size_t)row * D + colv]; }
            }
            float cp0[8], cp1[8]; float a0 = 1.f, a1 = 1.f;
#pragma unroll
            for (int i = 0; i < 8; ++i) { a0 *= f0[i]; cp0[i] = a0; a1 *= f1[i]; cp1[i] = a1; }
            *(LAS f32x2*)(lds + O_SEG + (wv * 128 + 2 * lane) * 4) = (f32x2){a0, a1};
            LDS_BARRIER();
            float P0 = 1.f, P1 = 1.f, T0 = 1.f, T1 = 1.f;
#pragma unroll
            for (int w2 = 0; w2 < 8; ++w2) { const f32x2 t = *(const LAS f32x2*)(lds + O_SEG + (w2 * 128 + 2 * lane) * 4); T0 *= t.x; T1 *= t.y; if (w2 < wv) { P0 *= t.x; P1 *= t.y; } }
            {
                float kd0[8], kd1[8];
#pragma unroll
                for (int i = 0; i < 8; ++i) {
                    const int j = wv * 8 + i;
                    const float eg0 = P0 * cp0[i], eg1 = P1 * cp1[i];
                    const float ie0 = __builtin_amdgcn_rcpf(eg0), ie1 = __builtin_amdgcn_rcpf(eg1);
                    const float kt0 = (1.f - f0[i]) * ie0, kt1 = (1.f - f1[i]) * ie1;
                    kd0[i] = kt0 * T0; kd1[i] = kt1 * T1;
                    *(LAS unsigned*)(lds + O_QT + buf * 64 * QSTR + j * QSTR + 4 * lane) = cvt_pk_bf16(q0[i] * eg0, q1[i] * eg1);
                    *(LAS unsigned*)(lds + O_KT + j * QSTR + 4 * lane) = cvt_pk_bf16(kt0, kt1);
                }
                u32x4 k0, k1;
                k0.x = cvt_pk_bf16(kd0[0], kd0[1]); k0.y = cvt_pk_bf16(kd0[2], kd0[3]); k0.z = cvt_pk_bf16(kd0[4], kd0[5]); k0.w = cvt_pk_bf16(kd0[6], kd0[7]);
                k1.x = cvt_pk_bf16(kd1[0], kd1[1]); k1.y = cvt_pk_bf16(kd1[2], kd1[3]); k1.z = cvt_pk_bf16(kd1[4], kd1[5]); k1.w = cvt_pk_bf16(kd1[6], kd1[7]);
                *(LAS u32x4*)(lds + O_KDT + (2 * lane) * SSTR + wv * 16) = k0;
                *(LAS u32x4*)(lds + O_KDT + (2 * lane + 1) * SSTR + wv * 16) = k1;
                if (wv == 0) *(LAS f32x2*)(lds + O_DEC + 8 * lane) = (f32x2){T0, T1};
                u32x4 vv; vv.x = cvt_pk_bf16(vf[0], vf[1]); vv.y = cvt_pk_bf16(vf[2], vf[3]); vv.z = cvt_pk_bf16(vf[4], vf[5]); vv.w = cvt_pk_bf16(vf[6], vf[7]);
                *(LAS u32x4*)(lds + O_VT + buf * 64 * SSTR + lane * SSTR + wv * 16) = vv;
            }
            if (c >= 5) o_step(c - 1);
            LDS_BARRIER();
            const int nxt = buf ^ 1;
            if (lat) {
#pragma unroll
                for (int rep = 0; rep < 2; ++rep) {
                    const int idx = wv + rep * 8, ti = idx >> 2, si = idx & 3;
                    f32x4 cacc = {0.f, 0.f, 0.f, 0.f};
                    if (si <= ti) {
#pragma unroll
                        for (int kk = 0; kk < 4; ++kk) {
                            const bf16x8 a = *(const LAS bf16x8*)(lds + O_KT + (16 * si + fr) * QSTR + (32 * kk + 8 * fq) * 2);
                            const bf16x8 bq = *(const LAS bf16x8*)(lds + O_QT + buf * 64 * QSTR + (16 * ti + fr) * QSTR + (32 * kk + 8 * fq) * 2);
                            cacc = __builtin_amdgcn_mfma_f32_16x16x32_bf16(a, bq, cacc, 0, 0, 0);
                        }
                        const int t = 16 * ti + fr, s0 = 16 * si + 4 * fq;
#pragma unroll
                        for (int j = 0; j < 4; ++j) cacc[j] = (s0 + j <= t) ? cacc[j] : 0.f;
                    }
                    u32x2 wv2; wv2.x = cvt_pk_bf16(cacc[0], cacc[1]); wv2.y = cvt_pk_bf16(cacc[2], cacc[3]);
                    *(LAS u32x2*)(lds + O_ATT + (16 * ti + fr) * SSTR + (16 * si + 4 * fq) * 2) = wv2;
                }
            }
            {
                const f32x4 d4 = *(const LAS f32x4*)(lds + O_DEC + (16 * wv + 4 * fq) * 4);
#pragma unroll
                for (int ei = 0; ei < 4; ++ei) {
                    Sacc[ei] = Sacc[ei] * d4;
#pragma unroll
                    for (int kk = 0; kk < 2; ++kk) {
                        const bf16x8 a = *(const LAS bf16x8*)(lds + O_KDT + (16 * wv + fr) * SSTR + (32 * kk + 8 * fq) * 2);
                        const bf16x8 bb = *(const LAS bf16x8*)(lds + O_VT + buf * 64 * SSTR + (16 * ei + fr) * SSTR + (32 * kk + 8 * fq) * 2);
                        Sacc[ei] = __builtin_amdgcn_mfma_f32_16x16x32_bf16(a, bb, Sacc[ei], 0, 0, 0);
                    }
                    u32x2 sw; sw.x = cvt_pk_bf16(Sacc[ei][0], Sacc[ei][1]); sw.y = cvt_pk_bf16(Sacc[ei][2], Sacc[ei][3]);
                    *(LAS u32x2*)(lds + O_ST + nxt * 64 * QSTR + (16 * ei + fr) * QSTR + (16 * wv + 4 * fq) * 2) = sw;
                }
            }
            LDS_BARRIER();
        }
        o_step(131);
        LDS_BARRIER();
    }
}

#define XB_TMO      128
#define XB_XCNT(j)  (256  + 64 * (j))
#define XB_XSUB(j)  (1280 + 64 * (j))
#define XB_XGEN(j)  (2304 + 64 * (j))
#define XB_TOP      3328
#define XB_TOPGEN   3392
#define XCD_BAR_WORDS 3456
#define XB_SPIN_CAP (1u << 18)
DI unsigned xb_ld(unsigned* p)              { return __hip_atomic_load(p, __ATOMIC_RELAXED, __HIP_MEMORY_SCOPE_AGENT); }
DI unsigned xb_add(unsigned* p, unsigned v) { return __hip_atomic_fetch_add(p, v, __ATOMIC_RELAXED, __HIP_MEMORY_SCOPE_AGENT); }
DI unsigned xb_xcc_id() { return (unsigned)__builtin_amdgcn_s_getreg((3 << 11) | 20) & 0xFu; }
#define XB_SPIN(cond, bar) do { unsigned _sp = 0; while (cond) { __builtin_amdgcn_s_sleep(1); \
    if ((++_sp & 255u) == 0u) { if (xb_ld(&(bar)[XB_TMO])) break; if (_sp > XB_SPIN_CAP) { atomicAdd(&(bar)[XB_TMO], 1u); break; } } } } while (0)
struct XcdBarrier { unsigned* bar; unsigned x; volatile LAS unsigned* st; };
DI XcdBarrier xcd_barrier_post(unsigned* bar, volatile LAS unsigned* st) {
    XcdBarrier b; b.bar = bar; b.x = xb_xcc_id(); b.st = st;
    if (threadIdx.x == 0) (void)xb_add(&bar[XB_XCNT(b.x)], 1u);
    return b;
}
DI void xcd_barrier_complete(unsigned* bar, unsigned x, unsigned& nloc, unsigned& nx) {
    const unsigned G = gridDim.x * gridDim.y * gridDim.z;
    unsigned sum, cnt, mine, sp = 0u;
    for (;;) {
        sum = 0u; cnt = 0u; mine = 0u;
#pragma unroll
        for (unsigned j = 0; j < 16; ++j) { const unsigned c = xb_ld(&bar[XB_XCNT(j)]); sum += c; cnt += (c > 0u) ? 1u : 0u; mine = (j == x) ? c : mine; }
        if (sum == G) break;
        __builtin_amdgcn_s_sleep(1);
        if ((++sp & 255u) == 0u) { if (xb_ld(&bar[XB_TMO])) break; if (sp > XB_SPIN_CAP) { atomicAdd(&bar[XB_TMO], 1u); break; } }
    }
    nloc = mine > 0u ? mine : 1u; nx = cnt > 0u ? cnt : 1u;
}
DI void xcd_barrier(const XcdBarrier& b) {
    asm volatile("s_waitcnt vmcnt(0)" ::: "memory");
    __syncthreads();
    if (threadIdx.x == 0) {
        unsigned* bar = b.bar;
        __builtin_amdgcn_s_waitcnt(0);
        unsigned nloc = b.st[0], nx = b.st[1];
        if (nloc == 0u) { xcd_barrier_complete(bar, b.x, nloc, nx); b.st[0] = nloc; b.st[1] = nx; }
        const unsigned old = xb_add(&bar[XB_XSUB(b.x)], 1u);
        const unsigned gen = old / nloc;
        if (old + 1u == (gen + 1u) * nloc) {
            __builtin_amdgcn_fence(__ATOMIC_RELEASE, "agent");
            asm volatile("s_waitcnt vmcnt(0)" ::: "memory");
            const unsigned og = xb_add(&bar[XB_TOP], 1u);
            const unsigned tg = og / nx;
            if (og + 1u == (tg + 1u) * nx) xb_add(&bar[XB_TOPGEN], 1u);
            else XB_SPIN(xb_ld(&bar[XB_TOPGEN]) == tg, bar);
            __builtin_amdgcn_fence(__ATOMIC_ACQUIRE, "agent");
            xb_add(&bar[XB_XGEN(b.x)], 1u);
            asm volatile("s_waitcnt vmcnt(0)" ::: "memory");
        } else {
            XB_SPIN(xb_ld(&bar[XB_XGEN(b.x)]) == gen, bar);
            __builtin_amdgcn_fence(__ATOMIC_ACQUIRE, "agent");
            asm volatile("s_waitcnt vmcnt(0)" ::: "memory");
        }
    }
    __syncthreads();
}

#ifdef PLAIN_LAUNCH
DI void my_grid_sync(unsigned* ctr, unsigned target) {
    __syncthreads();
    if (threadIdx.x == 0) {
        __builtin_amdgcn_fence(__ATOMIC_RELEASE, "agent");
        __hip_atomic_fetch_add(ctr, 1u, __ATOMIC_RELAXED, __HIP_MEMORY_SCOPE_AGENT);
        while (__hip_atomic_load(ctr, __ATOMIC_RELAXED, __HIP_MEMORY_SCOPE_AGENT) < target) __builtin_amdgcn_s_sleep(1);
        __builtin_amdgcn_fence(__ATOMIC_ACQUIRE, "agent");
    }
    __syncthreads();
}
#endif
__global__ void __launch_bounds__(NTHREADS, 2) mega(Params p) {
    extern __shared__ __attribute__((aligned(16))) unsigned char lds_raw[];
    LAS unsigned char* lds = (LAS unsigned char*)lds_raw;
    cg::grid_group grid = cg::this_grid();
    unsigned char* ws = p.ws;
    const float* mods = (const float*)(ws + OFF_MODS);
    const float* shw = (const float*)(ws + OFF_SHW);
    float* ssq = (float*)(ws + OFF_SSQ);
    float* hctx = (float*)(ws + OFF_HCTX);
    const int G = gridDim.x, bid = blockIdx.x;
    const int wave_id = __builtin_amdgcn_readfirstlane((int)threadIdx.x >> 6);
    volatile LAS unsigned* xb_st = (volatile LAS unsigned*)(lds + 139264);
    if (threadIdx.x < 4) xb_st[threadIdx.x] = 0u;
    __syncthreads();
    const XcdBarrier xbar = xcd_barrier_post((unsigned*)(ws + OFF_BAR), xb_st);
#ifdef PROBE_LO
    unsigned long long t_lo = 0, t_hi = 0;
#endif
    for (int ph = p.ph_lo; ph < p.ph_hi; ++ph) {
#ifdef PROBE_LO
        if (ph == PROBE_LO) t_lo = __builtin_amdgcn_s_memrealtime();
        if (ph == PROBE_HI) t_hi = __builtin_amdgcn_s_memrealtime();
#ifdef PROBE_FINAL
        if (ph == 17) { t_lo = __builtin_amdgcn_s_memrealtime(); final_phase(p, wave_id); grid.sync(); t_hi = __builtin_amdgcn_s_memrealtime(); }
#endif
        if (ph == 17) { if (bid == 0 && threadIdx.x == 0) { const float ticks = (float)(t_hi - t_lo); *(float*)(ws + OFF_DBG) = sqrtf(0.01035f * ticks * 1e-6f); } grid.sync(); }
#endif
        if (PHON(0) && ph == 0) prep0(lds, p, wave_id);
        else if (PHON(1) && ph == 1) prep1(lds, p, wave_id);
        else if (PHON(2) && (ph == 2 || ph == 7 || ph == 9 || ph == 15)) {
            const int fi = ph == 2 ? 0 : ph == 7 ? 1 : ph == 9 ? 2 : 3;
            const int sl = ph == 2 ? 0 : ph == 7 ? 2 : ph == 9 ? 3 : 5;
            const int M = ph == 15 ? ML : MT;
            const bf16_t* A = (const bf16_t*)(ws + (ph == 15 ? OFF_S4 : OFF_S0));
            pg8::Gemm g{A, (const bf16_t*)(ws + OFF_WGU + fi * SZ_WGU1), M, 2 * FF, D, 0, 0};
            pg8::StaticOrder S; S.init(M, 2 * FF, G, bid, ph == 2 ? 0 : 1, 4);
            EpiSwiglu E{ssq, shw + (size_t)sl * 9 * SHW_LD, (bf16_t*)(ws + OFF_S1)};
            pg8::gemm_phase<EpiSwiglu>(lds, g, S, E, wave_id);
        } else if (PHON(3) && (ph == 3 || ph == 8 || ph == 10 || ph == 6 || ph == 14)) {
            const bool ffn = (ph == 3 || ph == 8 || ph == 10);
            const int fi = ph == 3 ? 0 : ph == 8 ? 1 : 2;
            const int sl = ph == 3 ? 0 : ph == 6 ? 1 : ph == 8 ? 2 : ph == 10 ? 3 : 4;
            const int l = sl / 3, j = sl % 3, sn = sl + 1, ln = sn / 3, jn = sn % 3;
            const int M = ph == 14 ? ML : MT;
            const bf16_t* A = ffn ? (const bf16_t*)(ws + OFF_S1) : ph == 6 ? (const bf16_t*)(ws + OFF_S3) : (const bf16_t*)(ws + OFF_S0);
            const bf16_t* Bt = ffn ? (const bf16_t*)(ws + OFF_WDN + fi * SZ_WDN1) : ph == 6 ? (const bf16_t*)(ws + OFF_WCOUT) : (const bf16_t*)(ws + OFF_WHOUT);
            pg8::Gemm g{A, Bt, M, D, ffn ? FF : D, ffn ? 1 : 0, ffn ? 1 : 0};
            pg8::StaticOrder S; S.init(M, D, G, bid, ph == 3 ? 1 : 0);
            const EpiRes<true> E{ph == 3 ? p.x : p.out, ph == 3 ? p.ctx : hctx, p.out, hctx,
                                 mods + (size_t)l * 9 * NMOD + (3 * j + 2) * 1024, p.norm_g + (ln * 3 + jn) * 1024, mods + (size_t)ln * 9 * NMOD + (3 * jn + 1) * 1024,
                                 (bf16_t*)(ws + (ph == 14 ? OFF_S4 : OFF_S0)), ssq, ffn ? 0.5f : 1.0f, 0.f};
            pg8::gemm_phase<EpiRes<true>>(lds, g, S, E, wave_id);
        } else if (PHON(16) && ph == 16) {
            pg8::Gemm g{(const bf16_t*)(ws + OFF_S1), (const bf16_t*)(ws + OFF_WDN + 3 * SZ_WDN1), ML, D, FF, 1, 1};
            pg8::StaticOrder S; S.init(ML, D, G, bid, 0);
            const EpiRes<false> E{p.out, hctx, (float*)(ws + OFF_S4), hctx, mods + (size_t)1 * 9 * NMOD + 8 * 1024, p.norm_g, mods, nullptr, ssq, 0.5f, 0.f};
            pg8::gemm_phase<EpiRes<false>>(lds, g, S, E, wave_id);
        } else if (PHON(4) && ph == 4) {
            pg8::Gemm g{(const bf16_t*)(ws + OFF_S0), (const bf16_t*)(ws + OFF_WCIN), MT, 3 * D, D, 0, 0};
            pg8::StaticOrder S; S.init(MT, 3 * D, G, bid, 0, 4);
            EpiConvIn E{ssq, shw + (size_t)1 * 9 * SHW_LD, (bf16_t*)(ws + OFF_S1), (bf16_t*)(ws + OFF_S2)};
            pg8::gemm_phase<EpiConvIn>(lds, g, S, E, wave_id);
        } else if (PHON(5) && ph == 5) conv_phase(p, wave_id);
        else if (PHON(11) && ph == 11) {
            pg8::Gemm g{(const bf16_t*)(ws + OFF_S0), (const bf16_t*)(ws + OFF_WHIN), MT, 5 * D, D, 0, 0};
            pg8::StaticOrder S; S.init(MT, 5 * D, G, bid, 1, 4);
            EpiHgIn E{ssq, shw + (size_t)4 * 9 * SHW_LD, (const float*)(ws + OFF_LB), (bf16_t*)(ws + OFF_S4), (bf16_t*)(ws + OFF_S1), (bf16_t*)(ws + OFF_S2), (bf16_t*)(ws + OFF_S3), (bf16_t*)(ws + OFF_S5)};
            pg8::gemm_phase<EpiHgIn>(lds, g, S, E, wave_id);
        } else if (PHON(12) && ph == 12) scan_phase(lds, p, wave_id);
        else if (PHON(13) && ph == 13) gate_phase(p, wave_id);
        else if (PHON(17) && ph == 17) final_phase(p, wave_id);
#ifdef PLAIN_LAUNCH
        if (ph + 1 < p.ph_hi) my_grid_sync((unsigned*)(ws + OFF_DBG + 128), (unsigned)(ph + 1) * gridDim.x);
#else
        if (ph + 1 < p.ph_hi) { if (ph == 0) grid.sync(); else xcd_barrier(xbar); }
#endif
    }
}

extern "C" void kernel_launch(void* const* d_in, const int* in_sizes, int n_in, void* d_out, int out_size, void* d_ws, size_t ws_size, hipStream_t stream) {
    static int grid = 0;
    if (grid == 0) {
        if (n_in != 17 || ws_size < WS_END || out_size != ML * D) { fprintf(stderr, "kernel_launch: unexpected shapes (n_in %d, ws %zu < %zu?, out %d)\n", n_in, ws_size, (size_t)WS_END, out_size); grid = -1; return; }
        int dev = 0, cus = 0, per_cu = 0;
        hipGetDevice(&dev);
        hipDeviceGetAttribute(&cus, hipDeviceAttributeMultiprocessorCount, dev);
        if (hipFuncSetAttribute((const void*)mega, hipFuncAttributeMaxDynamicSharedMemorySize, LDS_BYTES) != hipSuccess) { fprintf(stderr, "kernel_launch: hipFuncSetAttribute failed\n"); grid = -1; return; }
        if (hipOccupancyMaxActiveBlocksPerMultiprocessor(&per_cu, (const void*)mega, NTHREADS, LDS_BYTES) != hipSuccess || per_cu < 1) { fprintf(stderr, "kernel_launch: occupancy query gives %d\n", per_cu); per_cu = 1; }
        (void)hipGetLastError();
        grid = cus * 1;
    }
    if (grid < 0) return;
    Params p{};
    const float** pp = (const float**)&p;
    for (int i = 0; i < 17; ++i) pp[i] = (const float*)d_in[i];
    p.out = (float*)d_out; p.ws = (unsigned char*)d_ws; p.ph_lo = 0; p.ph_hi = NPHASES;
    void* args[] = {&p};
#ifdef PLAIN_LAUNCH
    (void)hipMemsetAsync((char*)d_ws + OFF_DBG, 0, 256, stream);
    hipLaunchKernelGGL(mega, dim3(grid), dim3(NTHREADS), LDS_BYTES, stream, p);
    hipError_t e = hipPeekAtLastError(); (void)args;
#else
    (void)hipMemsetAsync((char*)d_ws + OFF_BAR, 0, 16384, stream);
    hipError_t e = hipLaunchCooperativeKernel((const void*)mega, dim3(grid), dim3(NTHREADS), args, LDS_BYTES, stream);
#endif
    if (e != hipSuccess) fprintf(stderr, "cooperative launch failed: %s (grid %d)\n", hipGetErrorString(e), grid);
}
```

```cpp
#include <hip/hip_runtime.h>
#include <hip/hip_cooperative_groups.h>
#include <cstdio>
namespace cg = cooperative_groups;

#define LAS __attribute__((address_space(3)))
#define DI __device__ __forceinline__
typedef unsigned short bf16_t;
typedef short bf16x8 __attribute__((ext_vector_type(8)));
typedef float f32x4 __attribute__((ext_vector_type(4)));
typedef unsigned u32x4 __attribute__((ext_vector_type(4)));
typedef unsigned u32x2 __attribute__((ext_vector_type(2)));

constexpr int D = 1024, NB = 8, SEQ = 8192, LC = 256, FF = 2816;
constexpr int ML = NB * SEQ;
constexpr int MC = NB * LC;
constexpr int MT = ML + MC;
constexpr int NMOD = 9 * D;
constexpr int SHW_LD = 5632;
constexpr float EPS = 1e-6f;
constexpr int NTHREADS = 512;
constexpr int LDS_BYTES = 139264 + 1024;
constexpr int NPHASES = 18;
#ifndef PHSEL
#define PHSEL 0x3FFFF
#endif
#define PHON(k) (((PHSEL) >> (k)) & 1)

constexpr size_t R2 = (size_t)MT * D * 2, L2B = (size_t)ML * D * 2;
constexpr size_t SZ_WGU1 = (size_t)2 * FF * D * 2, SZ_WDN1 = (size_t)D * FF * 2;
constexpr size_t OFF_WGU = 0;
constexpr size_t OFF_WDN = OFF_WGU + 4 * SZ_WGU1;
constexpr size_t OFF_WCIN = OFF_WDN + 4 * SZ_WDN1;
constexpr size_t OFF_WCOUT = OFF_WCIN + (size_t)3 * D * D * 2;
constexpr size_t OFF_WHIN = OFF_WCOUT + (size_t)D * D * 2;
constexpr size_t OFF_WHOUT = OFF_WHIN + (size_t)5 * D * D * 2;
constexpr size_t OFF_MODS = OFF_WHOUT + (size_t)D * D * 2;
constexpr size_t OFF_SHW = OFF_MODS + (size_t)2 * 9 * NMOD * 4;
constexpr size_t OFF_LB = OFF_SHW + (size_t)6 * 9 * SHW_LD * 4;
constexpr size_t OFF_DBG = OFF_LB + 2 * 1024 * 4;
constexpr size_t OFF_BAR = OFF_DBG + 256;
constexpr size_t OFF_SSQ = OFF_BAR + 16384;
constexpr size_t OFF_HCTX = OFF_SSQ + (size_t)MT * 16 * 4;
constexpr size_t OFF_S0 = ((OFF_HCTX + (size_t)MC * D * 4 + 4095) / 4096) * 4096;
constexpr size_t OFF_S1 = OFF_S0 + R2;
constexpr size_t OFF_S2 = OFF_S1 + R2;
constexpr size_t OFF_S3 = OFF_S2 + R2;
constexpr size_t OFF_S4 = OFF_S3 + R2;
constexpr size_t OFF_S5 = OFF_S4 + L2B;
constexpr size_t OFF_S6 = OFF_S5 + L2B;
constexpr size_t WS_END = OFF_S6 + L2B;
static_assert((size_t)MT * FF * 2 <= 3 * R2, "act fits in S1..S3");
static_assert(WS_END <= (size_t)1073741824, "workspace budget");

struct Params {
    const float *x, *c, *ctx, *c_ctx, *ada_w, *ada_b, *norm_g, *w_gu, *w_dn, *cw_in, *cw, *cw_out, *hw_in, *lb_logits, *gnorm, *hw_out, *final_g;
    float* out; unsigned char* ws; int ph_lo, ph_hi;
};

DI unsigned cvt_pk_bf16(float lo, float hi) { typedef __bf16 bf2 __attribute__((ext_vector_type(2))); bf2 v = {(__bf16)lo, (__bf16)hi}; return __builtin_bit_cast(unsigned, v); }
DI unsigned pk_f16(float a, float b) { typedef _Float16 h2 __attribute__((ext_vector_type(2))); h2 v = {(_Float16)a, (_Float16)b}; return __builtin_bit_cast(unsigned, v); }
DI float bf_lo(unsigned u) { return __uint_as_float(u << 16); }
DI float bf_hi(unsigned u) { return __uint_as_float(u & 0xffff0000u); }
DI float silu_f(float x) { return x * __builtin_amdgcn_rcpf(1.f + __expf(-x)); }
DI float sigmoid_f(float x) { return __builtin_amdgcn_rcpf(1.f + __expf(-x)); }
DI u32x4 pack8(const f32x4 a, const f32x4 b) { u32x4 w; w.x = cvt_pk_bf16(a[0], a[1]); w.y = cvt_pk_bf16(a[2], a[3]); w.z = cvt_pk_bf16(b[0], b[1]); w.w = cvt_pk_bf16(b[2], b[3]); return w; }
DI float row_rstd(const float* ssq, int row) {
    const f32x4* p = (const f32x4*)(ssq + (size_t)row * 16);
    const f32x4 a = p[0], b = p[1], c = p[2], d = p[3];
    const f32x4 s = (a + b) + (c + d);
    const float t = (s[0] + s[1]) + (s[2] + s[3]);
    return rsqrtf(t * (1.f / 1024.f) + EPS);
}
DI void rows_rstd(const float* ssq, int row0, int fq, float (&rs)[2][4]) {
    f32x4 v[2][4];
#pragma unroll
    for (int ai = 0; ai < 2; ++ai)
#pragma unroll
        for (int m = 0; m < 4; ++m) v[ai][m] = *(const f32x4*)(ssq + (size_t)(row0 + ai * 128 + m * 16) * 16 + 4 * fq);
#pragma unroll
    for (int ai = 0; ai < 2; ++ai)
#pragma unroll
        for (int m = 0; m < 4; ++m) {
            float t = (v[ai][m][0] + v[ai][m][1]) + (v[ai][m][2] + v[ai][m][3]);
            t += __shfl_xor(t, 16); t += __shfl_xor(t, 32);
            rs[ai][m] = rsqrtf(t * (1.f / 1024.f) + EPS);
        }
}
DI int opaque_tid(int wave_id) { unsigned z = 0u; asm volatile("" : "+v"(z)); return (int)__builtin_amdgcn_mbcnt_hi(~0u, __builtin_amdgcn_mbcnt_lo(~0u, z)) + wave_id * 64; }
#define LDS_BARRIER() do { asm volatile("s_waitcnt lgkmcnt(0)" ::: "memory"); __builtin_amdgcn_s_barrier(); asm volatile("" ::: "memory"); } while (0)

namespace pg8 {
constexpr int BM = 256, BK = 64, HALF = 128, HTB = HALF * BK * 2, STAGE_BYTES = 8 * HTB, NXCD = 8, WGM = 8;
DI int lds_byte(int r, int c) { const int st = (r >> 4) * 2 + (c >> 5), rr = r & 15, cc = c & 31, ob = rr * 64 + cc * 2; return st * 1024 + (ob ^ (((ob >> 9) & 1) << 5)); }
DI void stage_rc(int b, int& R, int& C) { const int st = b / 1024, sb = b % 1024, swz = sb ^ (((sb >> 9) & 1) << 5); R = (st >> 1) * 16 + swz / 64; C = (st & 1) * 32 + (swz % 64) / 2; }
DI int perm32(int rho) { const int n = rho >> 4, i = rho & 15; return 8 * (i >> 2) + 4 * n + (i & 3); }
struct Unit { int pm, pn; };
struct Gemm { const bf16_t* A; const bf16_t* Bt; int M, N, K; int a_tm; int b_tm; };
struct StaticOrder {
    int nM, nN, nwg, G, c, rev;
    DI void init(int M, int N, int G_, int c_, int rev_ = 0) { nM = M / BM; nN = N / BM; nwg = nM * nN; G = G_; c = c_; rev = rev_; }
    DI bool next(int i, Unit& u) const {
        const long L = (long)i * G + c; if (L >= nwg) return false;
        int wgid = (int)L; { const int q = nwg / NXCD, r = nwg % NXCD, xcd = wgid % NXCD, off = wgid / NXCD; wgid = (xcd < r ? xcd * (q + 1) : r * (q + 1) + (xcd - r) * q) + off; }
        const int nig = WGM * nN, gid = wgid / nig, fm = gid * WGM, gsz = (nM - fm) < WGM ? (nM - fm) : WGM;
        u.pm = fm + ((wgid % nig) % gsz); u.pn = (wgid % nig) / gsz; if (rev) u.pm = nM - 1 - u.pm; return true;
    }
};

template <class Epi>
DI void gemm_phase(LAS unsigned char* lds, const Gemm g, const StaticOrder& S, const Epi& E, const int wave_id) {
    const int tid = opaque_tid(wave_id), wid = __builtin_amdgcn_readfirstlane(tid >> 6), lane = tid & 63, wr = wid >> 2, wc = wid & 3, fr = lane & 15, fq = lane >> 4;
    const int K = g.K, nt = K / BK;
    unsigned voffA[2], voffB[2];
#pragma unroll
    for (int i = 0; i < 2; ++i) { int R, C; stage_rc(tid * 16 + i * 8192, R, C); const int Rb = Epi::PERM ? ((R & ~31) + perm32(R & 31)) : R;
        voffA[i] = (unsigned)(R * (g.a_tm ? BK : K) + C) * 2u; voffB[i] = (unsigned)(Rb * (g.b_tm ? BK : K) + C) * 2u; }
    const size_t kstep = g.b_tm ? (size_t)(BM * BK * 2) : (size_t)(BK * 2);
    const size_t hstep = g.b_tm ? (size_t)(HALF * BK * 2) : (size_t)HALF * K * 2;
    const size_t tstep = g.b_tm ? (size_t)nt * (BM * BK * 2) : (size_t)BM * K * 2;
    const size_t kstepA = g.a_tm ? (size_t)(BM * BK * 2) : (size_t)(BK * 2);
    const size_t hstepA = g.a_tm ? (size_t)(HALF * BK * 2) : (size_t)HALF * K * 2;
    const size_t tstepA = g.a_tm ? (size_t)nt * (BM * BK * 2) : (size_t)BM * K * 2;
    const unsigned ldsw = (unsigned)wid * 1024u;
    const int aoff = lds_byte(wr * 64 + fr, fq * 8), boff = lds_byte(wc * 32 + fr, fq * 8);
#define PG8_SA(b, h) (((b) * 2 + (h)) * HTB)
#define PG8_SB(b, h) ((4 + (b) * 2 + (h)) * HTB)
#define PG8_STAGE(bufoff, gbase, voff) do { _Pragma("unroll") for (int _i = 0; _i < 2; ++_i) \
        __builtin_amdgcn_global_load_lds((const unsigned*)((const char*)(gbase) + (voff)[_i]), (LAS unsigned*)(lds + (bufoff) + ldsw + _i * 8192), 16, 0, 0); } while (0)
#define PG8_LDA(dst, b, h) do { _Pragma("unroll") for (int m = 0; m < 4; ++m) _Pragma("unroll") for (int k = 0; k < 2; ++k) dst[m][k] = *(const LAS bf16x8*)(lds + PG8_SA(b, h) + aoff + m * 2048 + k * 1024); } while (0)
#define PG8_LDB(dst, b, h) do { _Pragma("unroll") for (int n = 0; n < 2; ++n) _Pragma("unroll") for (int k = 0; k < 2; ++k) dst[n][k] = *(const LAS bf16x8*)(lds + PG8_SB(b, h) + boff + n * 2048 + k * 1024); } while (0)
#define PG8_MMA(ai, bj, At, Bt) do { __builtin_amdgcn_s_setprio(1); _Pragma("unroll") for (int m = 0; m < 4; ++m) _Pragma("unroll") for (int n = 0; n < 2; ++n) _Pragma("unroll") for (int k = 0; k < 2; ++k) \
        acc[ai][bj][m][n] = __builtin_amdgcn_mfma_f32_16x16x32_bf16(Bt[n][k], At[m][k], acc[ai][bj][m][n], 0, 0, 0); __builtin_amdgcn_s_setprio(0); } while (0)
#define PG8_WAIT_V(n) asm volatile("s_waitcnt vmcnt(" #n ")" ::: "memory")
#define PG8_WAIT_L(n) asm volatile("s_waitcnt lgkmcnt(" #n ")" ::: "memory")
#define PG8_BAR __builtin_amdgcn_s_barrier()
#define PG8_SCHED __builtin_amdgcn_sched_barrier(0)
    Unit cur, nxt; int ui = 0;
    if (!S.next(0, cur)) return;
    f32x4 acc[2][2][4][2];
#pragma unroll
    for (int a = 0; a < 2; ++a)
#pragma unroll
        for (int b = 0; b < 2; ++b)
#pragma unroll
            for (int m = 0; m < 4; ++m)
#pragma unroll
                for (int n = 0; n < 2; ++n) acc[a][b][m][n] = (f32x4){0.f, 0.f, 0.f, 0.f};
    bf16x8 At[4][2], B0[2][2], B1[2][2];
    const char* cA = (const char*)g.A + (size_t)cur.pm * tstepA; const char* cB = (const char*)g.Bt + (size_t)cur.pn * tstep;
    PG8_STAGE(PG8_SB(0, 0), cB, voffB); PG8_STAGE(PG8_SB(0, 1), cB + hstep, voffB); PG8_STAGE(PG8_SA(0, 0), cA, voffA); PG8_STAGE(PG8_SA(0, 1), cA + hstepA, voffA);
    if (wr == 1) PG8_BAR;
    PG8_WAIT_V(2); PG8_BAR;
    PG8_STAGE(PG8_SB(1, 0), cB + kstep, voffB); PG8_STAGE(PG8_SA(1, 0), cA + kstepA, voffA); PG8_STAGE(PG8_SB(1, 1), cB + hstep + kstep, voffB);
    PG8_WAIT_V(6); PG8_BAR;
    for (;;) {
        const bool has_next = S.next(ui + 1, nxt);
        const char* nA = has_next ? (const char*)g.A + (size_t)nxt.pm * tstepA : cA; const char* nB = has_next ? (const char*)g.Bt + (size_t)nxt.pn * tstep : cB;
        for (int t = 0; t < nt; t += 2) {
            const bool last = (t == nt - 2);
            const char* a1 = cA + (size_t)(t + 1) * kstepA;
            const char* a2 = last ? nA : cA + (size_t)(t + 2) * kstepA; const char* b2 = last ? nB : cB + (size_t)(t + 2) * kstep;
            const char* a3 = a2 + kstepA; const char* b3 = b2 + kstep;
            PG8_LDB(B0, 0, 0); PG8_LDB(B1, 0, 1); PG8_SCHED; PG8_LDA(At, 0, 0); PG8_STAGE(PG8_SA(1, 1), a1 + hstepA, voffA);
            PG8_WAIT_V(8); PG8_WAIT_L(0); PG8_BAR; PG8_MMA(0, 0, At, B0); PG8_MMA(0, 1, At, B1); PG8_BAR; PG8_SCHED;
            PG8_LDA(At, 0, 1); PG8_STAGE(PG8_SB(0, 0), b2, voffB); PG8_STAGE(PG8_SB(0, 1), b2 + hstep, voffB); PG8_STAGE(PG8_SA(0, 0), a2, voffA);
            PG8_WAIT_V(8); PG8_WAIT_L(0); PG8_BAR; PG8_MMA(1, 0, At, B0); PG8_MMA(1, 1, At, B1); PG8_BAR; PG8_SCHED;
            PG8_LDB(B0, 1, 0); PG8_LDB(B1, 1, 1); PG8_SCHED; PG8_LDA(At, 1, 0); PG8_STAGE(PG8_SA(0, 1), a2 + hstepA, voffA);
            PG8_WAIT_V(8); PG8_WAIT_L(0); PG8_BAR; PG8_MMA(0, 0, At, B0); PG8_MMA(0, 1, At, B1); PG8_BAR; PG8_SCHED;
            PG8_LDA(At, 1, 1); PG8_STAGE(PG8_SB(1, 0), b3, voffB); PG8_STAGE(PG8_SB(1, 1), b3 + hstep, voffB); PG8_STAGE(PG8_SA(1, 0), a3, voffA);
            PG8_WAIT_V(8); PG8_WAIT_L(0); PG8_BAR; PG8_MMA(1, 0, At, B0); PG8_MMA(1, 1, At, B1); PG8_BAR; PG8_SCHED;
        }
        if (wr == 0) PG8_BAR;
        PG8_SCHED; asm volatile("" ::: "memory");
        E(acc, cur, wr, wc, fr, fq);
        asm volatile("" ::: "memory"); PG8_SCHED;
        if (!has_next) break;
#pragma unroll
        for (int a = 0; a < 2; ++a)
#pragma unroll
            for (int b = 0; b < 2; ++b)
#pragma unroll
                for (int m = 0; m < 4; ++m)
#pragma unroll
                    for (int n = 0; n < 2; ++n) acc[a][b][m][n] = (f32x4){0.f, 0.f, 0.f, 0.f};
        cur = nxt; cA = nA; cB = nB; ++ui;
        if (wr == 1) PG8_BAR;
    }
    PG8_WAIT_V(0);
    PG8_BAR;
#undef PG8_SA
#undef PG8_SB
#undef PG8_STAGE
#undef PG8_LDA
#undef PG8_LDB
#undef PG8_MMA
#undef PG8_WAIT_V
#undef PG8_WAIT_L
#undef PG8_BAR
#undef PG8_SCHED
}
}
using pg8::Unit;

struct EpiSwiglu {
    static constexpr bool PERM = true;
    const float* ssq; const float* shw; bf16_t* act;
    DI void operator()(const f32x4 (&acc)[2][2][4][2], const Unit& u, int wr, int wc, int fr, int fq) const {
        const int mr = u.pm < 256 ? (u.pm >> 5) : 8;
        const int nb = u.pn * 256 + wc * 32 + 8 * fq;
        const int fb = u.pn * 128 + wc * 32 + 8 * fq;
        const int row0 = u.pm * 256 + wr * 64 + fr;
        const float* sp = shw + (size_t)mr * SHW_LD + nb;
        const f32x4 sg0 = *(const f32x4*)(sp), sg1 = *(const f32x4*)(sp + 4), su0 = *(const f32x4*)(sp + 128), su1 = *(const f32x4*)(sp + 132);
        float rs[2][4];
        rows_rstd(ssq, row0, fq, rs);
#pragma unroll
        for (int ai = 0; ai < 2; ++ai)
#pragma unroll
            for (int m = 0; m < 4; ++m) {
                const int row = row0 + ai * 128 + m * 16;
                const float r1 = rs[ai][m];
                const f32x4 g0 = acc[ai][0][m][0] * r1 + sg0, g1 = acc[ai][0][m][1] * r1 + sg1;
                const f32x4 u0 = acc[ai][1][m][0] * r1 + su0, u1 = acc[ai][1][m][1] * r1 + su1;
                f32x4 a0, a1;
#pragma unroll
                for (int j = 0; j < 4; ++j) { a0[j] = silu_f(g0[j]) * u0[j]; a1[j] = silu_f(g1[j]) * u1[j]; }
                *(u32x4*)(act + (((size_t)(u.pm * 44 + 2 * u.pn + (wc >> 1)) * 256 + (ai * 128 + wr * 64 + m * 16 + fr)) * 64 + (wc & 1) * 32 + 8 * fq)) = pack8(a0, a1);
            }
    }
};
template <bool WA, bool HF32> struct EpiRes {
    static constexpr bool PERM = true;
    const float* hinf_lat; const float* hinf_ctx;
    const bf16_t* hinb_lat; const bf16_t* hinb_ctx;
    bf16_t* hout_lat; bf16_t* hout_ctx;
    const float* cvec; const float* gvec; const float* svec; bf16_t* Aout; float* ssq; float cmul; int hin_f32;
    DI void operator()(const f32x4 (&acc)[2][2][4][2], const Unit& u, int wr, int wc, int fr_in, int fq_in) const {
        (void)fr_in; (void)fq_in;
        unsigned z_ = 0u; float cmul_o = cmul;
        asm volatile("" : "+v"(z_), "+v"(cmul_o));
        const int lane_ = (int)__builtin_amdgcn_mbcnt_hi(~0u, __builtin_amdgcn_mbcnt_lo(~0u, z_));
        const int fr = lane_ & 15, fq = lane_ >> 4;
        const int mr = u.pm < 256 ? (u.pm >> 5) : 8;
        const int cb = u.pn * 256 + wc * 32 + 8 * fq;
        const int row0 = u.pm * 256 + wr * 64 + fr;
        const bool lat = u.pm < 256;
        const float* hif = lat ? hinf_lat : hinf_ctx;
        const bf16_t* hib = lat ? hinb_lat : hinb_ctx;
        bf16_t* hob = lat ? hout_lat : hout_ctx;
        const unsigned rb = (unsigned)(lat ? row0 : row0 - ML) * (unsigned)D;
        float ss[2][4];
#pragma unroll
        for (int ai = 0; ai < 2; ++ai)
#pragma unroll
            for (int m = 0; m < 4; ++m) ss[ai][m] = 0.f;
        f32x4 cf[2][2], gs[2][2];
#define ER_COEF(bj) do { const int c = cb + (bj) * 128; \
            cf[bj][0] = *(const f32x4*)(cvec + (size_t)mr * NMOD + c) * cmul_o; cf[bj][1] = *(const f32x4*)(cvec + (size_t)mr * NMOD + c + 4) * cmul_o; \
            if (WA) { gs[bj][0] = *(const f32x4*)(gvec + c) * (*(const f32x4*)(svec + (size_t)mr * NMOD + c) + 1.f); gs[bj][1] = *(const f32x4*)(gvec + c + 4) * (*(const f32x4*)(svec + (size_t)mr * NMOD + c + 4) + 1.f); } } while (0)
#define ER_OFF(bj, ai, m) (rb + (unsigned)(((ai) * 128 + (m) * 16) * D + cb + (bj) * 128))
#define ER_ROW(h0, h1, bj, ai, m) do { const unsigned ro = ER_OFF(bj, ai, m); \
            const f32x4 n0 = (h0) + cf[bj][0] * acc[ai][bj][m][0], n1 = (h1) + cf[bj][1] * acc[ai][bj][m][1]; \
            *(u32x4*)(hob + ro) = pack8(n0, n1); \
            ss[ai][m] += ((n0[0] * n0[0] + n0[1] * n0[1]) + (n0[2] * n0[2] + n0[3] * n0[3])) + ((n1[0] * n1[0] + n1[1] * n1[1]) + (n1[2] * n1[2] + n1[3] * n1[3])); \
            if (WA) *(u32x4*)(Aout + (unsigned)((row0 + (ai) * 128 + (m) * 16) * D + cb + (bj) * 128)) = pack8(n0 * gs[bj][0], n1 * gs[bj][1]); } while (0)
#define ER_FENCE asm volatile("" ::: "memory")
        ER_COEF(0);
        if constexpr (HF32) {
#define ER_LOADF(hv, bj, ai) do { _Pragma("unroll") for (int m = 0; m < 4; ++m) { const unsigned ro = ER_OFF(bj, ai, m); hv[m][0] = *(const f32x4*)(hif + ro); hv[m][1] = *(const f32x4*)(hif + ro + 4); } } while (0)
#define ER_PROCF(hv, bj, ai) do { _Pragma("unroll") for (int m = 0; m < 4; ++m) ER_ROW(hv[m][0], hv[m][1], bj, ai, m); } while (0)
            f32x4 h0[4][2];
            ER_LOADF(h0, 0, 0); ER_FENCE; ER_PROCF(h0, 0, 0); ER_FENCE;
            ER_LOADF(h0, 0, 1); ER_FENCE; ER_PROCF(h0, 0, 1); ER_FENCE;
            ER_COEF(1);
            ER_LOADF(h0, 1, 0); ER_FENCE; ER_PROCF(h0, 1, 0); ER_FENCE;
            ER_LOADF(h0, 1, 1); ER_FENCE; ER_PROCF(h0, 1, 1); ER_FENCE;
#undef ER_LOADF
#undef ER_PROCF
        } else {
#define ER_LOADB(rv, bj, ai) do { _Pragma("unroll") for (int m = 0; m < 4; ++m) rv[m] = *(const u32x4*)(hib + ER_OFF(bj, ai, m)); } while (0)
#define ER_PROCB(rv, bj, ai) do { _Pragma("unroll") for (int m = 0; m < 4; ++m) { const u32x4 w = rv[m]; \
            const f32x4 a0 = {bf_lo(w.x), bf_hi(w.x), bf_lo(w.y), bf_hi(w.y)}, a1 = {bf_lo(w.z), bf_hi(w.z), bf_lo(w.w), bf_hi(w.w)}; ER_ROW(a0, a1, bj, ai, m); } } while (0)
            u32x4 r0[4], r1[4], r2[4], r3[4];
            ER_LOADB(r0, 0, 0); ER_FENCE;
            ER_LOADB(r1, 0, 1); ER_FENCE;
            ER_PROCB(r0, 0, 0); ER_FENCE;
            ER_LOADB(r2, 1, 0); ER_COEF(1); ER_FENCE;
            ER_PROCB(r1, 0, 1); ER_FENCE;
            ER_LOADB(r3, 1, 1); ER_FENCE;
            ER_PROCB(r2, 1, 0); ER_FENCE;
            ER_PROCB(r3, 1, 1); ER_FENCE;
#undef ER_LOADB
#undef ER_PROCB
        }
#undef ER_COEF
#undef ER_OFF
#undef ER_ROW
#undef ER_FENCE
#pragma unroll
        for (int ai = 0; ai < 2; ++ai)
#pragma unroll
            for (int m = 0; m < 4; ++m) {
                float v = ss[ai][m];
                v += __shfl_xor(v, 16); v += __shfl_xor(v, 32);
                if (fq == 0) ssq[(unsigned)((row0 + ai * 128 + m * 16) * 16 + u.pn * 4 + wc)] = v;
            }
    }
};
struct EpiConvIn {
    static constexpr bool PERM = true;
    const float* ssq; const float* shw; bf16_t* bg; bf16_t* z;
    DI void operator()(const f32x4 (&acc)[2][2][4][2], const Unit& u, int wr, int wc, int fr, int fq) const {
        const int mr = u.pm < 256 ? (u.pm >> 5) : 8;
        const int nb = u.pn * 256 + wc * 32 + 8 * fq;
        const float* sp = shw + (size_t)mr * SHW_LD + nb;
        const f32x4 s00 = *(const f32x4*)(sp), s01 = *(const f32x4*)(sp + 4), s10 = *(const f32x4*)(sp + 128), s11 = *(const f32x4*)(sp + 132);
        const bool isbg = u.pn < 4;
        const int ch = (u.pn - 4) * 128 + wc * 32 + 8 * fq;
        float rsv[2][4];
        rows_rstd(ssq, u.pm * 256 + wr * 64 + fr, fq, rsv);
#pragma unroll
        for (int ai = 0; ai < 2; ++ai)
#pragma unroll
            for (int m = 0; m < 4; ++m) {
                const int row = u.pm * 256 + ai * 128 + wr * 64 + m * 16 + fr;
                const float rs = rsv[ai][m];
                const f32x4 v00 = acc[ai][0][m][0] * rs + s00, v01 = acc[ai][0][m][1] * rs + s01;
                const f32x4 v10 = acc[ai][1][m][0] * rs + s10, v11 = acc[ai][1][m][1] * rs + s11;
                if (isbg) {
                    *(u32x4*)(bg + (size_t)row * D + nb) = pack8(v00, v01);
                    *(u32x4*)(bg + (size_t)row * D + nb + 128) = pack8(v10, v11);
                } else {
                    *(u32x4*)(z + (size_t)row * D + ch) = pack8(v00 * v10, v01 * v11);
                }
            }
    }
};
struct EpiHgIn {
    static constexpr bool PERM = true;
    const float* ssq; const float* shw; const float* lb; bf16_t* q; bf16_t* v; bf16_t* lffw; bf16_t* lfbw; bf16_t* sog;
    DI void operator()(const f32x4 (&acc)[2][2][4][2], const Unit& u, int wr, int wc, int fr, int fq) const {
        const int mr = u.pm < 256 ? (u.pm >> 5) : 8;
        const int seg = u.pn >> 2;
        const int nb = u.pn * 256 + wc * 32 + 8 * fq;
        const int cc = nb - seg * 1024;
        const int row0 = u.pm * 256 + wr * 64 + fr;
        const float* sp = shw + (size_t)mr * SHW_LD + nb;
        if ((seg == 0 || seg == 4) && u.pm >= 256) return;
        float rs[2][4];
        rows_rstd(ssq, row0, fq, rs);
        if (seg == 2 || seg == 3) {
            bf16_t* dst = (seg == 2 ? lffw : lfbw) + (size_t)row0 * D + cc;
            const float* lbp = lb + (seg - 2) * 1024 + cc;
#pragma unroll
            for (int bj = 0; bj < 2; ++bj) {
                const f32x4 sh0 = *(const f32x4*)(sp + bj * 128), sh1 = *(const f32x4*)(sp + bj * 128 + 4);
                const f32x4 lb0 = *(const f32x4*)(lbp + bj * 128), lb1 = *(const f32x4*)(lbp + bj * 128 + 4);
#pragma unroll
                for (int ai = 0; ai < 2; ++ai)
#pragma unroll
                    for (int m = 0; m < 4; ++m) {
                        f32x4 a0 = acc[ai][bj][m][0] * rs[ai][m] + sh0, a1 = acc[ai][bj][m][1] * rs[ai][m] + sh1;
#pragma unroll
                        for (int j = 0; j < 4; ++j) {
                            a0[j] = lb0[j] + (1.f - lb0[j]) * sigmoid_f(a0[j]);
                            a1[j] = lb1[j] + (1.f - lb1[j]) * sigmoid_f(a1[j]);
                        }
                        u32x4 w; w.x = pk_f16(a0[0], a0[1]); w.y = pk_f16(a0[2], a0[3]); w.z = pk_f16(a1[0], a1[1]); w.w = pk_f16(a1[2], a1[3]);
                        *(u32x4*)(dst + (size_t)(ai * 128 + m * 16) * D + bj * 128) = w;
                    }
            }
        } else {
            bf16_t* pq = q; bf16_t* pv = v; bf16_t* ps = sog;
            asm volatile("" : "+s"(pq), "+s"(pv), "+s"(ps));
            bf16_t* dst = (seg == 0 ? pq : seg == 1 ? pv : ps) + (size_t)row0 * D + cc;
            const bool act = seg != 1;
#pragma unroll
            for (int bj = 0; bj < 2; ++bj) {
                const f32x4 sh0 = *(const f32x4*)(sp + bj * 128), sh1 = *(const f32x4*)(sp + bj * 128 + 4);
#pragma unroll
                for (int ai = 0; ai < 2; ++ai)
#pragma unroll
                    for (int m = 0; m < 4; ++m) {
                        f32x4 a0 = acc[ai][bj][m][0] * rs[ai][m] + sh0, a1 = acc[ai][bj][m][1] * rs[ai][m] + sh1;
                        if (act) {
#pragma unroll
                            for (int j = 0; j < 4; ++j) { a0[j] = silu_f(a0[j]); a1[j] = silu_f(a1[j]); }
                        }
                        *(u32x4*)(dst + (size_t)(ai * 128 + m * 16) * D + bj * 128) = pack8(a0, a1);
                    }
            }
        }
    }
};

DI void prep0(LAS unsigned char* lds, const Params& p, const int wave_id) {
    const int tid = opaque_tid(wave_id), G = gridDim.x, bid = blockIdx.x;
    float* mods = (float*)(p.ws + OFF_MODS);
    if (bid == 0) for (int i = tid; i < 2048; i += NTHREADS) { const float l0 = p.lb_logits[i], l1 = p.lb_logits[2048 + i]; ((float*)(p.ws + OFF_LB))[i] = 1.f / (1.f + __expf(l0 - l1)); }
    {
        LAS float* sS = (LAS float*)lds;
        LAS float* red = (LAS float*)(lds + 36864);
        if (bid < 288) {
            for (int i = tid; i < 9 * 1024; i += NTHREADS) { const int mr = i >> 10, k = i & 1023; const float v = mr < 8 ? p.c[mr * 1024 + k] : p.c_ctx[k]; sS[i] = v / (1.f + __expf(-v)); }
            __syncthreads();
            for (int t = bid; t < 288; t += G) {
                const int l = t / 144, cb = t % 144, kg = tid >> 6, cl = tid & 63, col = cb * 64 + cl;
                const float* W = p.ada_w + (size_t)l * 1024 * NMOD + col;
                float a[9];
#pragma unroll
                for (int mr = 0; mr < 9; ++mr) a[mr] = 0.f;
                for (int k = kg * 128; k < kg * 128 + 128; ++k) {
                    const float w = W[(size_t)k * NMOD];
#pragma unroll
                    for (int mr = 0; mr < 9; ++mr) a[mr] += sS[mr * 1024 + k] * w;
                }
#pragma unroll
                for (int mr = 0; mr < 9; ++mr) red[(kg * 9 + mr) * 64 + cl] = a[mr];
                __syncthreads();
                for (int i = tid; i < 576; i += NTHREADS) {
                    const int mr = i >> 6, c2 = i & 63; float s = 0.f;
#pragma unroll
                    for (int k2 = 0; k2 < 8; ++k2) s += red[(k2 * 9 + mr) * 64 + c2];
                    const int cc = cb * 64 + c2;
                    mods[(size_t)(l * 9 + mr) * NMOD + cc] = s + p.ada_b[l * NMOD + cc];
                }
                __syncthreads();
            }
        }
    }
    __syncthreads();
    LAS float* tile = (LAS float*)lds;
    struct TileDesc { const float* src; bf16_t* dst; int K; };
    auto tile_desc = [&](int t, const float*& srcp, bf16_t*& dstp, int& Kout) {
        const float* src; bf16_t* dst; int K, Ns, nT, kind; int tt = t;
        if (tt < 5632) { const int i = tt / 1408; tt %= 1408; src = p.w_gu + (size_t)i * 1024 * 5632; dst = (bf16_t*)(p.ws + OFF_WGU + i * SZ_WGU1); K = 1024; Ns = 5632; nT = 88; kind = 1; }
        else if (tt < 8448) { tt -= 5632; const int i = tt / 704; tt %= 704; src = p.w_dn + (size_t)i * 2816 * 1024; dst = (bf16_t*)(p.ws + OFF_WDN + i * SZ_WDN1); K = 2816; Ns = 1024; nT = 16; kind = 0; }
        else if (tt < 9216) { tt -= 8448; src = p.cw_in; dst = (bf16_t*)(p.ws + OFF_WCIN); K = 1024; Ns = 3072; nT = 48; kind = 2; }
        else if (tt < 9472) { tt -= 9216; src = p.cw_out; dst = (bf16_t*)(p.ws + OFF_WCOUT); K = 1024; Ns = 1024; nT = 16; kind = 0; }
        else if (tt < 10752) { tt -= 9472; src = p.hw_in; dst = (bf16_t*)(p.ws + OFF_WHIN); K = 1024; Ns = 5120; nT = 80; kind = 0; }
        else { tt -= 10752; src = p.hw_out; dst = (bf16_t*)(p.ws + OFF_WHOUT); K = 1024; Ns = 1024; nT = 16; kind = 0; }
        const int tk = tt / nT, tn = tt % nT, k0 = tk * 64, n0 = tn * 64;
        int sc0 = n0;
        if (kind == 1) { const int t2 = n0 >> 8, w = n0 & 255; sc0 = (w >> 7) * 2816 + t2 * 128 + (w & 127); }
        else if (kind == 2 && n0 >= 1024) { const int q = n0 - 1024, t2 = q >> 8, w = q & 255; sc0 = 1024 + (w >> 7) * 1024 + t2 * 128 + (w & 127); }
        srcp = src + (size_t)(k0 + (tid >> 4)) * Ns + sc0 + (tid & 15) * 4;
        { const int n = n0 + (tid >> 3);
          dstp = (t >= 5632 && t < 8448) ? dst + ((size_t)((n >> 8) * 44 + (k0 >> 6)) * 256 + (n & 255)) * 64 + (tid & 7) * 8
                                         : dst + (size_t)n * K + k0 + (tid & 7) * 8; }
        Kout = Ns;
    };
    {
        LAS float* tile2 = (LAS float*)(lds + 64 * 65 * 4);
        int t = bid;
        const float* srcp[2] = {nullptr, nullptr}; bf16_t* dstp[2] = {nullptr, nullptr}; int Ns[2] = {0, 0};
        f32x4 v[2][2];
#pragma unroll
        for (int k = 0; k < 2; ++k) { v[k][0] = (f32x4){0.f, 0.f, 0.f, 0.f}; v[k][1] = v[k][0];
            if (t + k * G < 11008) { tile_desc(t + k * G, srcp[k], dstp[k], Ns[k]); v[k][0] = *(const f32x4*)(srcp[k]); v[k][1] = *(const f32x4*)(srcp[k] + (size_t)32 * Ns[k]); } }
        while (t < 11008) {
            const int kk = tid >> 4, c4 = (tid & 15) * 4;
            bf16_t* dcur[2]; bool have[2];
#pragma unroll
            for (int k = 0; k < 2; ++k) {
                LAS float* tl = k ? tile2 : tile;
                tl[kk * 65 + c4 + 0] = v[k][0][0]; tl[kk * 65 + c4 + 1] = v[k][0][1]; tl[kk * 65 + c4 + 2] = v[k][0][2]; tl[kk * 65 + c4 + 3] = v[k][0][3];
                tl[(kk + 32) * 65 + c4 + 0] = v[k][1][0]; tl[(kk + 32) * 65 + c4 + 1] = v[k][1][1]; tl[(kk + 32) * 65 + c4 + 2] = v[k][1][2]; tl[(kk + 32) * 65 + c4 + 3] = v[k][1][3];
                dcur[k] = dstp[k]; have[k] = (t + k * G) < 11008;
            }
            const int tn = t + 2 * G;
#pragma unroll
            for (int k = 0; k < 2; ++k)
                if (tn + k * G < 11008) { tile_desc(tn + k * G, srcp[k], dstp[k], Ns[k]); v[k][0] = *(const f32x4*)(srcp[k]); v[k][1] = *(const f32x4*)(srcp[k] + (size_t)32 * Ns[k]); }
            LDS_BARRIER();
#pragma unroll
            for (int k = 0; k < 2; ++k) {
                if (have[k]) {
                    const LAS float* tl = k ? tile2 : tile;
                    const int n = tid >> 3, k8 = (tid & 7) * 8;
                    float v8[8];
#pragma unroll
                    for (int i = 0; i < 8; ++i) v8[i] = tl[(k8 + i) * 65 + n];
                    u32x4 o; o.x = cvt_pk_bf16(v8[0], v8[1]); o.y = cvt_pk_bf16(v8[2], v8[3]); o.z = cvt_pk_bf16(v8[4], v8[5]); o.w = cvt_pk_bf16(v8[6], v8[7]);
                    *(u32x4*)(dcur[k]) = o;
                }
            }
            LDS_BARRIER();
            t = tn;
        }
    }
}

DI void prep1(LAS unsigned char* lds, const Params& p, const int wave_id) {
    const int tid = opaque_tid(wave_id), G = gridDim.x, bid = blockIdx.x, wave = tid >> 6, lane = tid & 63;
    const float* mods = (const float*)(p.ws + OFF_MODS);
    float* shw = (float*)(p.ws + OFF_SHW);
    LAS float* sh = (LAS float*)lds;
    for (int sl = 0; sl < 6; ++sl) {
        const int l = sl / 3, j = sl % 3;
        const float* mv = mods + (size_t)l * 9 * NMOD + (3 * j) * 1024;
        for (int i = tid; i < 9216; i += NTHREADS) { const int mr = i >> 10, k = i & 1023; sh[i] = mv[(size_t)mr * NMOD + k]; }
        __syncthreads();
        const bf16_t* Wt; int N;
        if (sl == 0) { Wt = (const bf16_t*)(p.ws + OFF_WGU); N = 5632; }
        else if (sl == 1) { Wt = (const bf16_t*)(p.ws + OFF_WCIN); N = 3072; }
        else if (sl == 2) { Wt = (const bf16_t*)(p.ws + OFF_WGU + SZ_WGU1); N = 5632; }
        else if (sl == 3) { Wt = (const bf16_t*)(p.ws + OFF_WGU + 2 * SZ_WGU1); N = 5632; }
        else if (sl == 4) { Wt = (const bf16_t*)(p.ws + OFF_WHIN); N = 5120; }
        else { Wt = (const bf16_t*)(p.ws + OFF_WGU + 3 * SZ_WGU1); N = 5632; }
        for (int n = bid * 8 + wave; n < N; n += G * 8) {
            const u32x4* wp = (const u32x4*)(Wt + (size_t)n * 1024 + lane * 16);
            const u32x4 w0 = wp[0], w1 = wp[1];
            float wf[16];
#pragma unroll
            for (int i = 0; i < 4; ++i) { wf[2 * i] = bf_lo(w0[i]); wf[2 * i + 1] = bf_hi(w0[i]); wf[8 + 2 * i] = bf_lo(w1[i]); wf[8 + 2 * i + 1] = bf_hi(w1[i]); }
            float res = 0.f;
#pragma unroll
            for (int mr = 0; mr < 9; ++mr) {
                const LAS f32x4* sp = (const LAS f32x4*)(sh + mr * 1024 + lane * 16);
                float a = 0.f;
#pragma unroll
                for (int q4 = 0; q4 < 4; ++q4) { const f32x4 s = sp[q4]; a += s[0] * wf[4 * q4] + s[1] * wf[4 * q4 + 1] + s[2] * wf[4 * q4 + 2] + s[3] * wf[4 * q4 + 3]; }
#pragma unroll
                for (int off = 32; off >= 1; off >>= 1) a += __shfl_xor(a, off);
                if (lane == mr) res = a;
            }
            if (lane < 9) shw[(size_t)(sl * 9 + lane) * SHW_LD + n] = res;
        }
        __syncthreads();
    }
    bf16_t* A0 = (bf16_t*)(p.ws + OFF_S0);
    float* ssq = (float*)(p.ws + OFF_SSQ);
    const int NR = MT / 2;
    for (int r0 = bid * 8 + wave; r0 < NR; r0 += G * 8) {
        f32x4 xv[2][4];
#pragma unroll
        for (int k = 0; k < 2; ++k) {
            const int r = r0 + k * NR;
            const float* xr = r < ML ? p.x + (size_t)r * D : p.ctx + (size_t)(r - ML) * D;
#pragma unroll
            for (int q4 = 0; q4 < 4; ++q4) xv[k][q4] = *(const f32x4*)(xr + lane * 16 + 4 * q4);
        }
#pragma unroll
        for (int k = 0; k < 2; ++k) {
            const int r = r0 + k * NR;
            const int mr = r < ML ? (r >> 13) : 8;
            const float* gp = p.norm_g + lane * 16;
            const float* sc = mods + (size_t)mr * NMOD + 1024 + lane * 16;
            float ss = 0.f; f32x4 a[4];
#pragma unroll
            for (int q4 = 0; q4 < 4; ++q4) {
                const f32x4 x4 = xv[k][q4], gv = *(const f32x4*)(gp + 4 * q4), sv = *(const f32x4*)(sc + 4 * q4);
                ss += (x4[0] * x4[0] + x4[1] * x4[1]) + (x4[2] * x4[2] + x4[3] * x4[3]);
                a[q4] = x4 * gv * (sv + 1.f);
            }
#pragma unroll
            for (int off = 32; off >= 1; off >>= 1) ss += __shfl_xor(ss, off);
            u32x4* op = (u32x4*)(A0 + (size_t)r * D + lane * 16);
            op[0] = pack8(a[0], a[1]); op[1] = pack8(a[2], a[3]);
            if (lane < 16) ssq[(size_t)r * 16 + lane] = lane == 0 ? ss : 0.f;
        }
    }
}

DI void unpack8(const u32x4 w, float* f) {
#pragma unroll
    for (int i = 0; i < 4; ++i) { f[2 * i] = bf_lo(w[i]); f[2 * i + 1] = bf_hi(w[i]); }
}

DI void conv_phase(const Params& p, const int wave_id) {
    const int tid = opaque_tid(wave_id), G = gridDim.x, bid = blockIdx.x, wave = tid >> 6, lane = tid & 63;
    const bf16_t* bg = (const bf16_t*)(p.ws + OFF_S1); const bf16_t* z = (const bf16_t*)(p.ws + OFF_S2); bf16_t* U = (bf16_t*)(p.ws + OFF_S3);
    const int ch0 = lane * 16;
    float w0[16], w1[16], w2[16];
#pragma unroll
    for (int i = 0; i < 16; ++i) { w0[i] = p.cw[ch0 + i]; w1[i] = p.cw[1024 + ch0 + i]; w2[i] = p.cw[2048 + ch0 + i]; }
    const int NR = MT / 2;
    for (int rr = bid * 8 + wave; rr < NR; rr += G * 8) {
        const int r0 = NR - 1 - rr;
        u32x4 zp[2][2], zc[2][2], zn[2][2], bv[2][2];
#pragma unroll
        for (int k = 0; k < 2; ++k) {
            const int r = r0 + k * NR;
            bool hp, hn; int st;
            if (r < ML) {
                const int t = r & 8191, col = t & 63, ri = t >> 6;
                if (lane < 32) { hp = col > 0; hn = col < 63; st = 1; } else { hp = ri > 0; hn = ri < 127; st = 64; }
            } else { const int tc = (r - ML) & 255; hp = tc > 0; hn = tc < 255; st = 1; }
#pragma unroll
            for (int hf = 0; hf < 2; ++hf) {
                const size_t o = (size_t)r * D + ch0 + hf * 8;
                const u32x4 zero = {0u, 0u, 0u, 0u};
                zp[k][hf] = hp ? *(const u32x4*)(z + o - (size_t)st * D) : zero;
                zc[k][hf] = *(const u32x4*)(z + o);
                zn[k][hf] = hn ? *(const u32x4*)(z + o + (size_t)st * D) : zero;
                bv[k][hf] = *(const u32x4*)(bg + o);
            }
        }
#pragma unroll
        for (int k = 0; k < 2; ++k) {
            const int r = r0 + k * NR;
#pragma unroll
            for (int hf = 0; hf < 2; ++hf) {
                const size_t o = (size_t)r * D + ch0 + hf * 8;
                float fp[8], fc[8], fn[8], fb[8], r8[8];
                unpack8(zp[k][hf], fp); unpack8(zc[k][hf], fc); unpack8(zn[k][hf], fn); unpack8(bv[k][hf], fb);
#pragma unroll
                for (int i = 0; i < 8; ++i) r8[i] = fb[i] * (w0[hf * 8 + i] * fp[i] + w1[hf * 8 + i] * fc[i] + w2[hf * 8 + i] * fn[i]);
                u32x4 ov; ov.x = cvt_pk_bf16(r8[0], r8[1]); ov.y = cvt_pk_bf16(r8[2], r8[3]); ov.z = cvt_pk_bf16(r8[4], r8[5]); ov.w = cvt_pk_bf16(r8[6], r8[7]);
                *(u32x4*)(U + o) = ov;
            }
        }
    }
}

DI void gate_phase(const Params& p, const int wave_id) {
    const int tid = opaque_tid(wave_id), G = gridDim.x, bid = blockIdx.x, wave = tid >> 6, lane = tid & 63;
    bf16_t* X = (bf16_t*)(p.ws + OFF_S0); const bf16_t* Y = (const bf16_t*)(p.ws + OFF_S6); const bf16_t* sog = (const bf16_t*)(p.ws + OFF_S5);
    const int c0 = lane * 16;
    float gn[16];
#pragma unroll
    for (int i = 0; i < 16; ++i) gn[i] = p.gnorm[c0 + i];
    const int NR = ML / 2;
    for (int r0 = bid * 8 + wave; r0 < NR; r0 += G * 8) {
        u32x4 xv[2][2], yv[2][2], sgv[2][2];
#pragma unroll
        for (int k = 0; k < 2; ++k) {
            const size_t o = (size_t)(r0 + k * NR) * D + c0;
            xv[k][0] = *(const u32x4*)(X + o); xv[k][1] = *(const u32x4*)(X + o + 8);
            yv[k][0] = *(const u32x4*)(Y + o); yv[k][1] = *(const u32x4*)(Y + o + 8);
            sgv[k][0] = *(const u32x4*)(sog + o); sgv[k][1] = *(const u32x4*)(sog + o + 8);
        }
#pragma unroll
        for (int k = 0; k < 2; ++k) {
            const size_t o = (size_t)(r0 + k * NR) * D + c0;
            float ov[16], sv[16], a[8], b[8];
            unpack8(xv[k][0], a); unpack8(yv[k][0], b);
#pragma unroll
            for (int i = 0; i < 8; ++i) ov[i] = a[i] + b[i];
            unpack8(xv[k][1], a); unpack8(yv[k][1], b);
#pragma unroll
            for (int i = 0; i < 8; ++i) ov[8 + i] = a[i] + b[i];
            unpack8(sgv[k][0], sv); unpack8(sgv[k][1], sv + 8);
            float ss = 0.f;
#pragma unroll
            for (int i = 0; i < 16; ++i) ss += ov[i] * ov[i];
            ss += __shfl_xor(ss, 1); ss += __shfl_xor(ss, 2); ss += __shfl_xor(ss, 4);
            const float rs = rsqrtf(ss * (1.f / 128.f) + EPS);
            float r16[16];
#pragma unroll
            for (int i = 0; i < 16; ++i) r16[i] = ov[i] * rs * gn[i] * sv[i];
            u32x4 o0, o1;
            o0.x = cvt_pk_bf16(r16[0], r16[1]); o0.y = cvt_pk_bf16(r16[2], r16[3]); o0.z = cvt_pk_bf16(r16[4], r16[5]); o0.w = cvt_pk_bf16(r16[6], r16[7]);
            o1.x = cvt_pk_bf16(r16[8], r16[9]); o1.y = cvt_pk_bf16(r16[10], r16[11]); o1.z = cvt_pk_bf16(r16[12], r16[13]); o1.w = cvt_pk_bf16(r16[14], r16[15]);
            *(u32x4*)(X + o) = o0; *(u32x4*)(X + o + 8) = o1;
        }
    }
}

DI void final_phase(const Params& p, const int wave_id) {
    const int tid = opaque_tid(wave_id), G = gridDim.x, bid = blockIdx.x, wave = tid >> 6, lane = tid & 63;
    const float* ssq = (const float*)(p.ws + OFF_SSQ);
    f32x4 g[2][2];
#pragma unroll
    for (int q2 = 0; q2 < 2; ++q2) { g[q2][0] = *(const f32x4*)(p.final_g + q2 * 512 + lane * 8); g[q2][1] = *(const f32x4*)(p.final_g + q2 * 512 + lane * 8 + 4); }
    const int NR = ML / 2;
    for (int r0 = bid * 8 + wave; r0 < NR; r0 += G * 8) {
        u32x4 v[2][2]; float rs[2];
#pragma unroll
        for (int k = 0; k < 2; ++k) {
            const int r = r0 + k * NR;
            const bf16_t* hp = (const bf16_t*)(p.ws + OFF_S4) + (size_t)r * D + lane * 8;
#pragma unroll
            for (int q2 = 0; q2 < 2; ++q2) v[k][q2] = *(const u32x4*)(hp + q2 * 512);
            rs[k] = row_rstd(ssq, r);
        }
#pragma unroll
        for (int k = 0; k < 2; ++k) {
            const int r = r0 + k * NR;
            float* op = p.out + (size_t)r * D + lane * 8;
#pragma unroll
            for (int q2 = 0; q2 < 2; ++q2) {
                const u32x4 w = v[k][q2];
                f32x4 o0 = (f32x4){bf_lo(w.x), bf_hi(w.x), bf_lo(w.y), bf_hi(w.y)} * rs[k] * g[q2][0];
                f32x4 o1 = (f32x4){bf_lo(w.z), bf_hi(w.z), bf_lo(w.w), bf_hi(w.w)} * rs[k] * g[q2][1];
#ifdef PROBE_LO
                if (r < 256) { o0 = o0 + *(const float*)(p.ws + OFF_DBG); o1 = o1 + *(const float*)(p.ws + OFF_DBG); }
#endif
                *(f32x4*)(op + q2 * 512) = o0; *(f32x4*)(op + q2 * 512 + 4) = o1;
            }
        }
    }
}

DI void scan_phase(LAS unsigned char* lds, const Params& p, const int wave_id) {
    constexpr int QSTR = 272, SSTR = 144;
    constexpr int O_QT = 0, O_KT = 2 * 64 * QSTR, O_KDT = O_KT + 64 * QSTR, O_VT = O_KDT + 128 * SSTR, O_ATT = O_VT + 2 * 64 * SSTR, O_ST = O_ATT + 64 * SSTR,
                  O_SEG = O_ST + 2 * 64 * QSTR, O_DEC = O_SEG + 4096;
    static_assert(O_DEC + 512 <= 139264, "scan LDS");
    typedef float f32x2 __attribute__((ext_vector_type(2)));
    typedef _Float16 h2 __attribute__((ext_vector_type(2)));
    const int tid = opaque_tid(wave_id), wv = __builtin_amdgcn_readfirstlane(tid >> 6), lane = tid & 63, fr = lane & 15, fq = lane >> 4;
    const bf16_t* Qb = (const bf16_t*)(p.ws + OFF_S4); const bf16_t* Vb = (const bf16_t*)(p.ws + OFF_S1);
    for (int w = blockIdx.x; w < 256; w += gridDim.x) {
        const int xx = w & 7, yy = w >> 3, pair = xx * 8 + (yy >> 2), sub = yy & 3, dir = sub & 1, eh = sub >> 1, b = pair >> 3, h = pair & 7;
        const _Float16* FG = (const _Float16*)(p.ws + (dir ? OFF_S3 : OFF_S2));
        bf16_t* Ob = (bf16_t*)(p.ws + (dir ? OFF_S6 : OFF_S0));
        const int colq = h * 128 + 2 * lane, colv = h * 128 + eh * 64 + lane;
        f32x4 Sacc[4];
#pragma unroll
        for (int i = 0; i < 4; ++i) Sacc[i] = (f32x4){0.f, 0.f, 0.f, 0.f};
        for (int i = tid; i < 64 * QSTR / 4; i += NTHREADS) ((LAS unsigned*)(lds + O_ST))[i] = 0u;
        auto chunk_base = [&](int c) -> int {
            if (c < 4) return ML + b * 256 + (dir ? (3 - c) : c) * 64;
            return b * 8192 + (dir ? (127 - (c - 4)) : (c - 4)) * 64;
        };
        auto o_step = [&](int cc) {
            const int pb = cc & 1, obase = chunk_base(cc), ti = wv >> 1;
#pragma unroll
            for (int rep = 0; rep < 2; ++rep) {
                const int ei = (wv & 1) * 2 + rep;
                f32x4 oacc = {0.f, 0.f, 0.f, 0.f};
#pragma unroll
                for (int kk = 0; kk < 2; ++kk) {
                    const bf16x8 a = *(const LAS bf16x8*)(lds + O_VT + pb * 64 * SSTR + (16 * ei + fr) * SSTR + (32 * kk + 8 * fq) * 2);
                    const bf16x8 bb = *(const LAS bf16x8*)(lds + O_ATT + (16 * ti + fr) * SSTR + (32 * kk + 8 * fq) * 2);
                    oacc = __builtin_amdgcn_mfma_f32_16x16x32_bf16(a, bb, oacc, 0, 0, 0);
                }
#pragma unroll
                for (int kk = 0; kk < 4; ++kk) {
                    const bf16x8 a = *(const LAS bf16x8*)(lds + O_ST + pb * 64 * QSTR + (16 * ei + fr) * QSTR + (32 * kk + 8 * fq) * 2);
                    const bf16x8 bb = *(const LAS bf16x8*)(lds + O_QT + pb * 64 * QSTR + (16 * ti + fr) * QSTR + (32 * kk + 8 * fq) * 2);
                    oacc = __builtin_amdgcn_mfma_f32_16x16x32_bf16(a, bb, oacc, 0, 0, 0);
                }
                const int t = 16 * ti + fr; const int row = obase + (dir ? 63 - t : t);
                u32x2 ow; ow.x = cvt_pk_bf16(oacc[0], oacc[1]); ow.y = cvt_pk_bf16(oacc[2], oacc[3]);
                *(u32x2*)(Ob + (size_t)row * D + h * 128 + eh * 64 + 16 * ei + 4 * fq) = ow;
            }
        };
        unsigned fpk[8], qpk[8]; bf16_t vr[8];
        {
            const int base = chunk_base(0);
#pragma unroll
            for (int i = 0; i < 8; ++i) { const int j = wv * 8 + i; const int row = base + (dir ? 63 - j : j);
                fpk[i] = *(const unsigned*)(FG + (size_t)row * D + colq); qpk[i] = 0u; vr[i] = Vb[(size_t)row * D + colv]; }
        }
        LDS_BARRIER();
        for (int c = 0; c < 132; ++c) {
            const bool lat = c >= 4;
            const int buf = c & 1;
            float f0[8], f1[8], q0[8], q1[8], vf[8];
#pragma unroll
            for (int i = 0; i < 8; ++i) { const h2 hv = __builtin_bit_cast(h2, fpk[i]); f0[i] = (float)hv[0]; f1[i] = (float)hv[1]; q0[i] = bf_lo(qpk[i]); q1[i] = bf_hi(qpk[i]); vf[i] = __uint_as_float((unsigned)vr[i] << 16); }
            if (c + 1 < 132) {
                const int nb = chunk_base(c + 1); const bool nlat = (c + 1) >= 4;
#pragma unroll
                for (int i = 0; i < 8; ++i) { const int j = wv * 8 + i; const int row = nb + (dir ? 63 - j : j);
                    fpk[i] = *(const unsigned*)(FG + (size_t)row * D + colq); qpk[i] = nlat ? *(const unsigned*)(Qb + (size_t)row * D + colq) : 0u; vr[i] = Vb[(size_t)row * D + colv]; }
            }
            float cp0[8], cp1[8]; float a0 = 1.f, a1 = 1.f;
#pragma unroll
            for (int i = 0; i < 8; ++i) { a0 *= f0[i]; cp0[i] = a0; a1 *= f1[i]; cp1[i] = a1; }
            *(LAS f32x2*)(lds + O_SEG + (wv * 128 + 2 * lane) * 4) = (f32x2){a0, a1};
            LDS_BARRIER();
            float P0 = 1.f, P1 = 1.f, T0 = 1.f, T1 = 1.f;
#pragma unroll
            for (int w2 = 0; w2 < 8; ++w2) { const f32x2 t = *(const LAS f32x2*)(lds + O_SEG + (w2 * 128 + 2 * lane) * 4); T0 *= t.x; T1 *= t.y; if (w2 < wv) { P0 *= t.x; P1 *= t.y; } }
            {
                float kd0[8], kd1[8];
#pragma unroll
                for (int i = 0; i < 8; ++i) {
                    const int j = wv * 8 + i;
                    const float eg0 = P0 * cp0[i], eg1 = P1 * cp1[i];
                    const float ie0 = __builtin_amdgcn_rcpf(eg0), ie1 = __builtin_amdgcn_rcpf(eg1);
                    const float kt0 = (1.f - f0[i]) * ie0, kt1 = (1.f - f1[i]) * ie1;
                    kd0[i] = kt0 * T0; kd1[i] = kt1 * T1;
                    *(LAS unsigned*)(lds + O_QT + buf * 64 * QSTR + j * QSTR + 4 * lane) = cvt_pk_bf16(q0[i] * eg0, q1[i] * eg1);
                    *(LAS unsigned*)(lds + O_KT + j * QSTR + 4 * lane) = cvt_pk_bf16(kt0, kt1);
                }
                u32x4 k0, k1;
                k0.x = cvt_pk_bf16(kd0[0], kd0[1]); k0.y = cvt_pk_bf16(kd0[2], kd0[3]); k0.z = cvt_pk_bf16(kd0[4], kd0[5]); k0.w = cvt_pk_bf16(kd0[6], kd0[7]);
                k1.x = cvt_pk_bf16(kd1[0], kd1[1]); k1.y = cvt_pk_bf16(kd1[2], kd1[3]); k1.z = cvt_pk_bf16(kd1[4], kd1[5]); k1.w = cvt_pk_bf16(kd1[6], kd1[7]);
                *(LAS u32x4*)(lds + O_KDT + (2 * lane) * SSTR + wv * 16) = k0;
                *(LAS u32x4*)(lds + O_KDT + (2 * lane + 1) * SSTR + wv * 16) = k1;
                if (wv == 0) *(LAS f32x2*)(lds + O_DEC + 8 * lane) = (f32x2){T0, T1};
                u32x4 vv; vv.x = cvt_pk_bf16(vf[0], vf[1]); vv.y = cvt_pk_bf16(vf[2], vf[3]); vv.z = cvt_pk_bf16(vf[4], vf[5]); vv.w = cvt_pk_bf16(vf[6], vf[7]);
                *(LAS u32x4*)(lds + O_VT + buf * 64 * SSTR + lane * SSTR + wv * 16) = vv;
            }
            if (c >= 5) o_step(c - 1);
            LDS_BARRIER();
            const int nxt = buf ^ 1;
            if (lat) {
#pragma unroll
                for (int rep = 0; rep < 2; ++rep) {
                    const int idx = wv + rep * 8, ti = idx >> 2, si = idx & 3;
                    f32x4 cacc = {0.f, 0.f, 0.f, 0.f};
                    if (si <= ti) {
#pragma unroll
                        for (int kk = 0; kk < 4; ++kk) {
                            const bf16x8 a = *(const LAS bf16x8*)(lds + O_KT + (16 * si + fr) * QSTR + (32 * kk + 8 * fq) * 2);
                            const bf16x8 bq = *(const LAS bf16x8*)(lds + O_QT + buf * 64 * QSTR + (16 * ti + fr) * QSTR + (32 * kk + 8 * fq) * 2);
                            cacc = __builtin_amdgcn_mfma_f32_16x16x32_bf16(a, bq, cacc, 0, 0, 0);
                        }
                        const int t = 16 * ti + fr, s0 = 16 * si + 4 * fq;
#pragma unroll
                        for (int j = 0; j < 4; ++j) cacc[j] = (s0 + j <= t) ? cacc[j] : 0.f;
                    }
                    u32x2 wv2; wv2.x = cvt_pk_bf16(cacc[0], cacc[1]); wv2.y = cvt_pk_bf16(cacc[2], cacc[3]);
                    *(LAS u32x2*)(lds + O_ATT + (16 * ti + fr) * SSTR + (16 * si + 4 * fq) * 2) = wv2;
                }
            }
            {
                const f32x4 d4 = *(const LAS f32x4*)(lds + O_DEC + (16 * wv + 4 * fq) * 4);
#pragma unroll
                for (int ei = 0; ei < 4; ++ei) {
                    Sacc[ei] = Sacc[ei] * d4;
#pragma unroll
                    for (int kk = 0; kk < 2; ++kk) {
                        const bf16x8 a = *(const LAS bf16x8*)(lds + O_KDT + (16 * wv + fr) * SSTR + (32 * kk + 8 * fq) * 2);
                        const bf16x8 bb = *(const LAS bf16x8*)(lds + O_VT + buf * 64 * SSTR + (16 * ei + fr) * SSTR + (32 * kk + 8 * fq) * 2);
                        Sacc[ei] = __builtin_amdgcn_mfma_f32_16x16x32_bf16(a, bb, Sacc[ei], 0, 0, 0);
                    }
                    u32x2 sw; sw.x = cvt_pk_bf16(Sacc[ei][0], Sacc[ei][1]); sw.y = cvt_pk_bf16(Sacc[ei][2], Sacc[ei][3]);
                    *(LAS u32x2*)(lds + O_ST + nxt * 64 * QSTR + (16 * ei + fr) * QSTR + (16 * wv + 4 * fq) * 2) = sw;
                }
            }
            LDS_BARRIER();
        }
        o_step(131);
        LDS_BARRIER();
    }
}

#define XB_TMO      128
#define XB_XCNT(j)  (256  + 64 * (j))
#define XB_XSUB(j)  (1280 + 64 * (j))
#define XB_XGEN(j)  (2304 + 64 * (j))
#define XB_TOP      3328
#define XB_TOPGEN   3392
#define XCD_BAR_WORDS 3456
#define XB_SPIN_CAP (1u << 18)
DI unsigned xb_ld(unsigned* p)              { return __hip_atomic_load(p, __ATOMIC_RELAXED, __HIP_MEMORY_SCOPE_AGENT); }
DI unsigned xb_add(unsigned* p, unsigned v) { return __hip_atomic_fetch_add(p, v, __ATOMIC_RELAXED, __HIP_MEMORY_SCOPE_AGENT); }
DI unsigned xb_xcc_id() { return (unsigned)__builtin_amdgcn_s_getreg((3 << 11) | 20) & 0xFu; }
#define XB_SPIN(cond, bar) do { unsigned _sp = 0; while (cond) { __builtin_amdgcn_s_sleep(1); \
    if ((++_sp & 255u) == 0u) { if (xb_ld(&(bar)[XB_TMO])) break; if (_sp > XB_SPIN_CAP) { atomicAdd(&(bar)[XB_TMO], 1u); break; } } } } while (0)
struct XcdBarrier { unsigned* bar; unsigned x; volatile LAS unsigned* st; };
DI XcdBarrier xcd_barrier_post(unsigned* bar, volatile LAS unsigned* st) {
    XcdBarrier b; b.bar = bar; b.x = xb_xcc_id(); b.st = st;
    if (threadIdx.x == 0) (void)xb_add(&bar[XB_XCNT(b.x)], 1u);
    return b;
}
DI void xcd_barrier_complete(unsigned* bar, unsigned x, unsigned& nloc, unsigned& nx) {
    const unsigned G = gridDim.x * gridDim.y * gridDim.z;
    unsigned sum, cnt, mine, sp = 0u;
    for (;;) {
        sum = 0u; cnt = 0u; mine = 0u;
#pragma unroll
        for (unsigned j = 0; j < 16; ++j) { const unsigned c = xb_ld(&bar[XB_XCNT(j)]); sum += c; cnt += (c > 0u) ? 1u : 0u; mine = (j == x) ? c : mine; }
        if (sum == G) break;
        __builtin_amdgcn_s_sleep(1);
        if ((++sp & 255u) == 0u) { if (xb_ld(&bar[XB_TMO])) break; if (sp > XB_SPIN_CAP) { atomicAdd(&bar[XB_TMO], 1u); break; } }
    }
    nloc = mine > 0u ? mine : 1u; nx = cnt > 0u ? cnt : 1u;
}
DI void xcd_barrier(const XcdBarrier& b) {
    asm volatile("s_waitcnt vmcnt(0)" ::: "memory");
    __syncthreads();
    if (threadIdx.x == 0) {
        unsigned* bar = b.bar;
        __builtin_amdgcn_s_waitcnt(0);
        unsigned nloc = b.st[0], nx = b.st[1];
        if (nloc == 0u) { xcd_barrier_complete(bar, b.x, nloc, nx); b.st[0] = nloc; b.st[1] = nx; }
        const unsigned old = xb_add(&bar[XB_XSUB(b.x)], 1u);
        const unsigned gen = old / nloc;
        if (old + 1u == (gen + 1u) * nloc) {
            __builtin_amdgcn_fence(__ATOMIC_RELEASE, "agent");
            asm volatile("s_waitcnt vmcnt(0)" ::: "memory");
            const unsigned og = xb_add(&bar[XB_TOP], 1u);
            const unsigned tg = og / nx;
            if (og + 1u == (tg + 1u) * nx) xb_add(&bar[XB_TOPGEN], 1u);
            else XB_SPIN(xb_ld(&bar[XB_TOPGEN]) == tg, bar);
            __builtin_amdgcn_fence(__ATOMIC_ACQUIRE, "agent");
            xb_add(&bar[XB_XGEN(b.x)], 1u);
            asm volatile("s_waitcnt vmcnt(0)" ::: "memory");
        } else {
            XB_SPIN(xb_ld(&bar[XB_XGEN(b.x)]) == gen, bar);
            __builtin_amdgcn_fence(__ATOMIC_ACQUIRE, "agent");
            asm volatile("s_waitcnt vmcnt(0)" ::: "memory");
        }
    }
    __syncthreads();
}

#ifdef PLAIN_LAUNCH
DI void my_grid_sync(unsigned* ctr, unsigned target) {
    __syncthreads();
    if (threadIdx.x == 0) {
        __builtin_amdgcn_fence(__ATOMIC_RELEASE, "agent");
        __hip_atomic_fetch_add(ctr, 1u, __ATOMIC_RELAXED, __HIP_MEMORY_SCOPE_AGENT);
        while (__hip_atomic_load(ctr, __ATOMIC_RELAXED, __HIP_MEMORY_SCOPE_AGENT) < target) __builtin_amdgcn_s_sleep(1);
        __builtin_amdgcn_fence(__ATOMIC_ACQUIRE, "agent");
    }
    __syncthreads();
}
#endif
__global__ void __launch_bounds__(NTHREADS, 2) mega(Params p) {
    extern __shared__ __attribute__((aligned(16))) unsigned char lds_raw[];
    LAS unsigned char* lds = (LAS unsigned char*)lds_raw;
    cg::grid_group grid = cg::this_grid();
    unsigned char* ws = p.ws;
    const float* mods = (const float*)(ws + OFF_MODS);
    const float* shw = (const float*)(ws + OFF_SHW);
    float* ssq = (float*)(ws + OFF_SSQ);
    float* hctx = (float*)(ws + OFF_HCTX);
    const int G = gridDim.x, bid = blockIdx.x;
    const int wave_id = __builtin_amdgcn_readfirstlane((int)threadIdx.x >> 6);
    volatile LAS unsigned* xb_st = (volatile LAS unsigned*)(lds + 139264);
    if (threadIdx.x < 4) xb_st[threadIdx.x] = 0u;
    __syncthreads();
    const XcdBarrier xbar = xcd_barrier_post((unsigned*)(ws + OFF_BAR), xb_st);
#ifdef PROBE_LO
    unsigned long long t_lo = 0, t_hi = 0;
#endif
    for (int ph = p.ph_lo; ph < p.ph_hi; ++ph) {
#ifdef PROBE_LO
        if (ph == PROBE_LO) t_lo = __builtin_amdgcn_s_memrealtime();
        if (ph == PROBE_HI) t_hi = __builtin_amdgcn_s_memrealtime();
#ifdef PROBE_FINAL
        if (ph == 17) { t_lo = __builtin_amdgcn_s_memrealtime(); final_phase(p, wave_id); grid.sync(); t_hi = __builtin_amdgcn_s_memrealtime(); }
#endif
        if (ph == 17) { if (bid == 0 && threadIdx.x == 0) { const float ticks = (float)(t_hi - t_lo); *(float*)(ws + OFF_DBG) = sqrtf(0.01035f * ticks * 1e-6f); } grid.sync(); }
#endif
        if (PHON(0) && ph == 0) prep0(lds, p, wave_id);
        else if (PHON(1) && ph == 1) prep1(lds, p, wave_id);
        else if (PHON(2) && (ph == 2 || ph == 7 || ph == 9 || ph == 15)) {
            const int fi = ph == 2 ? 0 : ph == 7 ? 1 : ph == 9 ? 2 : 3;
            const int sl = ph == 2 ? 0 : ph == 7 ? 2 : ph == 9 ? 3 : 5;
            const int M = ph == 15 ? ML : MT;
            const bf16_t* A = (const bf16_t*)(ws + (ph == 15 ? OFF_S4 : OFF_S0));
            pg8::Gemm g{A, (const bf16_t*)(ws + OFF_WGU + fi * SZ_WGU1), M, 2 * FF, D, 0, 0};
            pg8::StaticOrder S; S.init(M, 2 * FF, G, bid, ph == 2 ? 0 : 1);
            EpiSwiglu E{ssq, shw + (size_t)sl * 9 * SHW_LD, (bf16_t*)(ws + OFF_S1)};
            pg8::gemm_phase<EpiSwiglu>(lds, g, S, E, wave_id);
        } else if (PHON(3) && (ph == 3 || ph == 8 || ph == 10 || ph == 6 || ph == 14)) {
            const bool ffn = (ph == 3 || ph == 8 || ph == 10);
            const int fi = ph == 3 ? 0 : ph == 8 ? 1 : 2;
            const int sl = ph == 3 ? 0 : ph == 6 ? 1 : ph == 8 ? 2 : ph == 10 ? 3 : 4;
            const int l = sl / 3, j = sl % 3, sn = sl + 1, ln = sn / 3, jn = sn % 3;
            const int M = ph == 14 ? ML : MT;
            const bf16_t* A = ffn ? (const bf16_t*)(ws + OFF_S1) : ph == 6 ? (const bf16_t*)(ws + OFF_S3) : (const bf16_t*)(ws + OFF_S0);
            const bf16_t* Bt = ffn ? (const bf16_t*)(ws + OFF_WDN + fi * SZ_WDN1) : ph == 6 ? (const bf16_t*)(ws + OFF_WCOUT) : (const bf16_t*)(ws + OFF_WHOUT);
            pg8::Gemm g{A, Bt, M, D, ffn ? FF : D, ffn ? 1 : 0, ffn ? 1 : 0};
            pg8::StaticOrder S; S.init(M, D, G, bid, ph == 3 ? 1 : 0);
            if (ph == 3) {
                const EpiRes<true, true> E{p.x, p.ctx, (const bf16_t*)p.out, (const bf16_t*)hctx, (bf16_t*)p.out, (bf16_t*)hctx,
                                     mods + (size_t)l * 9 * NMOD + (3 * j + 2) * 1024, p.norm_g + (ln * 3 + jn) * 1024, mods + (size_t)ln * 9 * NMOD + (3 * jn + 1) * 1024,
                                     (bf16_t*)(ws + OFF_S0), ssq, 0.5f, 1};
                pg8::gemm_phase<EpiRes<true, true>>(lds, g, S, E, wave_id);
            } else {
                const EpiRes<true, false> E{p.x, p.ctx, (const bf16_t*)p.out, (const bf16_t*)hctx, (bf16_t*)p.out, (bf16_t*)hctx,
                                     mods + (size_t)l * 9 * NMOD + (3 * j + 2) * 1024, p.norm_g + (ln * 3 + jn) * 1024, mods + (size_t)ln * 9 * NMOD + (3 * jn + 1) * 1024,
                                     (bf16_t*)(ws + (ph == 14 ? OFF_S4 : OFF_S0)), ssq, ffn ? 0.5f : 1.0f, 0};
                pg8::gemm_phase<EpiRes<true, false>>(lds, g, S, E, wave_id);
            }
        } else if (PHON(16) && ph == 16) {
            pg8::Gemm g{(const bf16_t*)(ws + OFF_S1), (const bf16_t*)(ws + OFF_WDN + 3 * SZ_WDN1), ML, D, FF, 1, 1};
            pg8::StaticOrder S; S.init(ML, D, G, bid, 0);
            const EpiRes<false, false> E{p.x, p.ctx, (const bf16_t*)p.out, (const bf16_t*)hctx, (bf16_t*)(ws + OFF_S4), (bf16_t*)hctx,
                                  mods + (size_t)1 * 9 * NMOD + 8 * 1024, p.norm_g, mods, nullptr, ssq, 0.5f, 0};
            pg8::gemm_phase<EpiRes<false, false>>(lds, g, S, E, wave_id);
        } else if (PHON(4) && ph == 4) {
            pg8::Gemm g{(const bf16_t*)(ws + OFF_S0), (const bf16_t*)(ws + OFF_WCIN), MT, 3 * D, D, 0, 0};
            pg8::StaticOrder S; S.init(MT, 3 * D, G, bid, 0);
            EpiConvIn E{ssq, shw + (size_t)1 * 9 * SHW_LD, (bf16_t*)(ws + OFF_S1), (bf16_t*)(ws + OFF_S2)};
            pg8::gemm_phase<EpiConvIn>(lds, g, S, E, wave_id);
        } else if (PHON(5) && ph == 5) conv_phase(p, wave_id);
        else if (PHON(11) && ph == 11) {
            pg8::Gemm g{(const bf16_t*)(ws + OFF_S0), (const bf16_t*)(ws + OFF_WHIN), MT, 5 * D, D, 0, 0};
            pg8::StaticOrder S; S.init(MT, 5 * D, G, bid, 1);
            EpiHgIn E{ssq, shw + (size_t)4 * 9 * SHW_LD, (const float*)(ws + OFF_LB), (bf16_t*)(ws + OFF_S4), (bf16_t*)(ws + OFF_S1), (bf16_t*)(ws + OFF_S2), (bf16_t*)(ws + OFF_S3), (bf16_t*)(ws + OFF_S5)};
            pg8::gemm_phase<EpiHgIn>(lds, g, S, E, wave_id);
        } else if (PHON(12) && ph == 12) scan_phase(lds, p, wave_id);
        else if (PHON(13) && ph == 13) gate_phase(p, wave_id);
        else if (PHON(17) && ph == 17) final_phase(p, wave_id);
#ifdef PLAIN_LAUNCH
        if (ph + 1 < p.ph_hi) my_grid_sync((unsigned*)(ws + OFF_DBG + 128), (unsigned)(ph + 1) * gridDim.x);
#else
        if (ph + 1 < p.ph_hi) { if (ph == 0) grid.sync(); else xcd_barrier(xbar); }
#endif
    }
}

extern "C" void kernel_launch(void* const* d_in, const int* in_sizes, int n_in, void* d_out, int out_size, void* d_ws, size_t ws_size, hipStream_t stream) {
    static int grid = 0;
    if (grid == 0) {
        if (n_in != 17 || ws_size < WS_END || out_size != ML * D) { fprintf(stderr, "kernel_launch: unexpected shapes (n_in %d, ws %zu < %zu?, out %d)\n", n_in, ws_size, (size_t)WS_END, out_size); grid = -1; return; }
        int dev = 0, cus = 0, per_cu = 0;
        hipGetDevice(&dev);
        hipDeviceGetAttribute(&cus, hipDeviceAttributeMultiprocessorCount, dev);
        if (hipFuncSetAttribute((const void*)mega, hipFuncAttributeMaxDynamicSharedMemorySize, LDS_BYTES) != hipSuccess) { fprintf(stderr, "kernel_launch: hipFuncSetAttribute failed\n"); grid = -1; return; }
        if (hipOccupancyMaxActiveBlocksPerMultiprocessor(&per_cu, (const void*)mega, NTHREADS, LDS_BYTES) != hipSuccess || per_cu < 1) { fprintf(stderr, "kernel_launch: occupancy query gives %d\n", per_cu); per_cu = 1; }
        (void)hipGetLastError();
        grid = cus * 1;
    }
    if (grid < 0) return;
    Params p{};
    const float** pp = (const float**)&p;
    for (int i = 0; i < 17; ++i) pp[i] = (const float*)d_in[i];
    p.out = (float*)d_out; p.ws = (unsigned char*)d_ws; p.ph_lo = 0; p.ph_hi = NPHASES;
    void* args[] = {&p};
#ifdef PLAIN_LAUNCH
    (void)hipMemsetAsync((char*)d_ws + OFF_DBG, 0, 256, stream);
    hipLaunchKernelGGL(mega, dim3(grid), dim3(NTHREADS), LDS_BYTES, stream, p);
    hipError_t e = hipPeekAtLastError(); (void)args;
#else
    (void)hipMemsetAsync((char*)d_ws + OFF_BAR, 0, 16384, stream);
    hipError_t e = hipLaunchCooperativeKernel((const void*)mega, dim3(grid), dim3(NTHREADS), args, LDS_BYTES, stream);
#endif
    if (e != hipSuccess) fprintf(stderr, "cooperative launch failed: %s (grid %d)\n", hipGetErrorString(e), grid);
}
```
